# Optimizing an MI355X kernel written in HIP

```python
import jax, jax.numpy as jnp
from jax import lax
import numpy as np

D_MODEL = 1024
BATCH = 8
SEQ = 2048
DEPTH = 4

N_META = 16
D_LRU = D_MODEL // 2
LRU_BLOCKS = 8
LRU_BLOCK_DIM = D_LRU // LRU_BLOCKS
CONV_WIDTH = 4
LRU_C = 8.0
D_RET = D_MODEL // 2
RET_HEADS = 4
RET_HEAD_DIM = D_RET // RET_HEADS
RET_CHUNK = 128
ROPE_BASE = 10000.0
D_MIX = D_LRU + D_RET
D_IN = 2 * D_LRU + 4 * D_RET
D_FF = -(-8 * D_MODEL // (3 * 256)) * 256
EPS = 1e-6

kernel_name = "hymba_rglru_retention_swiglu"


def rmsnorm(x, gain):
    x32 = x.astype(jnp.float32)
    y = x32 * lax.rsqrt(jnp.mean(x32 * x32, axis=-1, keepdims=True) + EPS)
    return (y * gain.astype(jnp.float32)).astype(x.dtype)


def rope(x, pos):
    half = x.shape[-1] // 2
    inv = ROPE_BASE ** (-jnp.arange(half, dtype=jnp.float32) / half)
    ang = pos[:, None] * inv[None, :]
    cos = jnp.cos(ang)[None, :, None, :]
    sin = jnp.sin(ang)[None, :, None, :]
    x1, x2 = x[..., :half], x[..., half:]
    return jnp.concatenate([x1 * cos - x2 * sin, x1 * sin + x2 * cos], axis=-1)


def rglru_group(xb, gate_b, conv_w, conv_b, wa, ba, wx, bx, lam, out_gain):
    B, T, _ = xb.shape
    xf = xb.astype(jnp.float32)
    xp = jnp.pad(xf, ((0, 0), (CONV_WIDTH - 1, 0), (0, 0)))
    xc = conv_b.astype(jnp.float32) + sum(
        xp[:, i:i + T, :] * conv_w[i].astype(jnp.float32) for i in range(CONV_WIDTH))
    blocks = xc.reshape(B, T, LRU_BLOCKS, LRU_BLOCK_DIM)
    r = jax.nn.sigmoid(jnp.einsum('btgi,gij->btgj', blocks, wa.astype(jnp.float32))
                       + ba.astype(jnp.float32)).reshape(B, T, D_LRU)
    ig = jax.nn.sigmoid(jnp.einsum('btgi,gij->btgj', blocks, wx.astype(jnp.float32))
                        + bx.astype(jnp.float32)).reshape(B, T, D_LRU)
    log_a = -LRU_C * r * jax.nn.softplus(-lam.astype(jnp.float32))
    a = jnp.exp(log_a)
    mult = jnp.sqrt(-jnp.expm1(2.0 * log_a))
    b = mult * (ig * xc)

    def combine(left, right):
        a1, b1 = left
        a2, b2 = right
        return a1 * a2, a2 * b1 + b2

    _, h = lax.associative_scan(combine, (a, b), axis=1)
    y = h * jax.nn.gelu(gate_b.astype(jnp.float32))
    return rmsnorm(y, out_gain).astype(xb.dtype)


def retention_group(q, k, v, g, gn_gain):
    B, T, _ = q.shape
    H, d, C = RET_HEADS, RET_HEAD_DIM, RET_CHUNK
    qf = q.astype(jnp.float32).reshape(B, T, H, d)
    kf = k.astype(jnp.float32).reshape(B, T, H, d)
    vf = v.astype(jnp.float32).reshape(B, T, H, d)
    pos = jnp.arange(T, dtype=jnp.float32)
    qf = rope(qf, pos)
    kf = rope(kf, pos) * (d ** -0.5)
    pad = (-T) % C
    padw = ((0, 0), (pad, 0), (0, 0), (0, 0))
    Tp = T + pad
    N = Tp // C
    qc = jnp.pad(qf, padw).reshape(B, N, C, H, d)
    kc = jnp.pad(kf, padw).reshape(B, N, C, H, d)
    vc = jnp.pad(vf, padw).reshape(B, N, C, H, d)

    log_g = jnp.log(1.0 - 2.0 ** (-5.0 - jnp.arange(H, dtype=jnp.float32)))
    idx = jnp.arange(C, dtype=jnp.float32)
    diff = idx[:, None] - idx[None, :]
    dmask = jnp.where(diff[None] >= 0,
                      jnp.exp(jnp.maximum(diff, 0.0)[None] * log_g[:, None, None]), 0.0)
    xi = jnp.exp((idx + 1.0)[:, None] * log_g[None, :])
    zeta = jnp.exp((C - 1.0 - idx)[:, None] * log_g[None, :])
    g_chunk = jnp.exp(C * log_g)

    scores = jnp.einsum('bnchd,bnshd->bnhcs', qc, kc) * dmask[None, None]
    y_intra = jnp.einsum('bnhcs,bnshe->bnche', scores, vc)

    def step(S, xs):
        qi, ki, vi = xs
        cross = jnp.einsum('bchd,bhde->bche', qi, S) * xi[None, :, :, None]
        S = S * g_chunk[None, :, None, None] + jnp.einsum(
            'bchd,bche->bhde', ki * zeta[None, :, :, None], vi)
        return S, cross

    S0 = jnp.zeros((B, H, d, d), jnp.float32)
    _, y_cross = lax.scan(step, S0, (jnp.moveaxis(qc, 1, 0),
                                     jnp.moveaxis(kc, 1, 0),
                                     jnp.moveaxis(vc, 1, 0)))
    y = (y_intra + jnp.moveaxis(y_cross, 0, 1)).reshape(B, Tp, H, d)[:, pad:]
    mu = jnp.mean(y, axis=-1, keepdims=True)
    var = jnp.mean(jnp.square(y - mu), axis=-1, keepdims=True)
    y = ((y - mu) * lax.rsqrt(var + EPS)).reshape(B, T, D_RET) * gn_gain.astype(jnp.float32)
    return (jax.nn.silu(g.astype(jnp.float32)) * y).astype(q.dtype)


def setup_inputs(seed: int = 0) -> dict:
    key = jax.random.key(seed)
    ks = jax.random.split(key, 24)
    f32 = jnp.float32

    def nrm(k, shape, scale):
        return jax.random.normal(k, shape, f32) * scale

    def gain(k, shape):
        return 1.0 + 0.02 * jax.random.normal(k, shape, f32)

    u = jax.random.uniform(ks[10], (DEPTH, D_LRU), f32, minval=0.9, maxval=0.999)
    s = u ** (1.0 / LRU_C)
    lru_lambda = jnp.log(s) - jnp.log1p(-s)
    return {
        "x": nrm(ks[0], (BATCH, SEQ, D_MODEL), 1.0),
        "meta_tokens": nrm(ks[1], (N_META, D_MODEL), 1.0),
        "norm_mix": gain(ks[2], (DEPTH, D_MODEL)),
        "w_in": nrm(ks[3], (DEPTH, D_MODEL, D_IN), D_MODEL ** -0.5),
        "conv_w": nrm(ks[4], (DEPTH, CONV_WIDTH, D_LRU), CONV_WIDTH ** -0.5),
        "conv_b": nrm(ks[5], (DEPTH, D_LRU), 0.01),
        "gate_a_w": nrm(ks[6], (DEPTH, LRU_BLOCKS, LRU_BLOCK_DIM, LRU_BLOCK_DIM), LRU_BLOCK_DIM ** -0.5),
        "gate_a_b": nrm(ks[7], (DEPTH, LRU_BLOCKS, LRU_BLOCK_DIM), 0.01),
        "gate_x_w": nrm(ks[8], (DEPTH, LRU_BLOCKS, LRU_BLOCK_DIM, LRU_BLOCK_DIM), LRU_BLOCK_DIM ** -0.5),
        "gate_x_b": nrm(ks[9], (DEPTH, LRU_BLOCKS, LRU_BLOCK_DIM), 0.01),
        "lru_lambda": lru_lambda,
        "lru_out_norm": gain(ks[11], (DEPTH, D_LRU)),
        "ret_out_norm": gain(ks[12], (DEPTH, D_RET)),
        "w_out": nrm(ks[13], (DEPTH, D_MIX, D_MODEL), D_MIX ** -0.5),
        "norm_ffn": gain(ks[14], (DEPTH, D_MODEL)),
        "w_gate": nrm(ks[15], (DEPTH, D_MODEL, D_FF), D_MODEL ** -0.5),
        "w_up": nrm(ks[16], (DEPTH, D_MODEL, D_FF), D_MODEL ** -0.5),
        "w_down": nrm(ks[17], (DEPTH, D_FF, D_MODEL), D_FF ** -0.5),
        "norm_final": gain(ks[18], (D_MODEL,)),
    }


def reference(x, meta_tokens, norm_mix, w_in, conv_w, conv_b, gate_a_w, gate_a_b,
              gate_x_w, gate_x_b, lru_lambda, lru_out_norm, ret_out_norm, w_out,
              norm_ffn, w_gate, w_up, w_down, norm_final):
    B = x.shape[0]
    meta = jnp.broadcast_to(meta_tokens[None].astype(x.dtype), (B, N_META, x.shape[-1]))
    h_res = jnp.concatenate([meta, x], axis=1)
    split_at = [D_LRU, 2 * D_LRU, 2 * D_LRU + D_RET, 2 * D_LRU + 2 * D_RET,
                2 * D_LRU + 3 * D_RET]
    for l in range(DEPTH):
        hn = rmsnorm(h_res, norm_mix[l])
        proj = hn @ w_in[l]
        x_lru, g_lru, q, k, v, g_ret = jnp.split(proj, split_at, axis=-1)
        y_lru = rglru_group(x_lru, g_lru, conv_w[l], conv_b[l], gate_a_w[l], gate_a_b[l],
                            gate_x_w[l], gate_x_b[l], lru_lambda[l], lru_out_norm[l])
        y_ret = retention_group(q, k, v, g_ret, ret_out_norm[l])
        h_res = h_res + jnp.concatenate([y_lru, y_ret], axis=-1) @ w_out[l]
        hn = rmsnorm(h_res, norm_ffn[l])
        h_res = h_res + (jax.nn.silu(hn @ w_gate[l]) * (hn @ w_up[l])) @ w_down[l]
    out = rmsnorm(h_res, norm_final)
    return out[:, N_META:, :]
```

```cpp
#include <hip/hip_runtime.h>
#include <hip/hip_cooperative_groups.h>
#include <cstdio>
#include <cstdint>
namespace cg = cooperative_groups;

#define LAS __attribute__((address_space(3)))
typedef unsigned short bf16_t;
typedef short bf16x8 __attribute__((ext_vector_type(8)));
typedef float f32x4 __attribute__((ext_vector_type(4)));
typedef float f32x2 __attribute__((ext_vector_type(2)));
typedef unsigned u32x4 __attribute__((ext_vector_type(4)));
typedef unsigned u32x2 __attribute__((ext_vector_type(2)));

constexpr int NB = 8, SEQ = 2048, NMETA = 16, TT = SEQ + NMETA, DM = 1024, DIN = 3072, DFF = 2816, DEPTH = 4;
constexpr int MROWS = NB * SEQ;
constexpr int XROWS = NB * TT;
constexpr int DLRU = 512, HD = 128, NH = 4;
constexpr float EPS = 1e-6f;
constexpr int C_XL = 0, C_Q = 512, C_K = 1024, C_GL = 1536, C_V = 2048, C_GR = 2560;
constexpr int NLC = 33;
constexpr int NRC = 17;

__host__ __device__ __forceinline__ int rowX_tile(int pm) { return pm * 256 + 16 * (pm >> 3) + 16; }
__device__ __forceinline__ int rowX(int m) { return m + 16 * (m >> 11) + 16; }

constexpr size_t MiB = 1u << 20;
constexpr size_t WS_ROPE = 1 * MiB;
constexpr size_t WS_SSQ = 3 * MiB;
constexpr size_t WS_HM = 4 * MiB;
constexpr size_t WS_SUMH = 5 * MiB, WS_SUML = 6 * MiB, WS_CARRY = 7 * MiB;
constexpr size_t WS_WAX = 8 * MiB;
constexpr size_t WS_W = 10 * MiB;
constexpr size_t W_IN_E = (size_t)DIN * DM, W_OUT_E = (size_t)DM * DM, W_GU_E = (size_t)2 * DFF * DM, W_D_E = (size_t)DM * DFF;
constexpr size_t W_LAYER_E = W_IN_E + W_OUT_E + W_GU_E + W_D_E;
constexpr size_t WS_HB = 108 * MiB;
constexpr size_t WS_PROJ = 141 * MiB;
constexpr size_t WS_END = 238 * MiB;
constexpr size_t LC_BATCH = (size_t)NLC * 8 * 4 * 4 * 64 * 16;
constexpr size_t WS_LC1 = WS_HB + 16 * MiB;
constexpr size_t WS_LC2 = WS_END;
constexpr size_t WS_END2 = WS_LC2 + 5 * LC_BATCH;
static_assert(16 * MiB + 8 * LC_BATCH <= (size_t)MROWS * DM * 4, "retention state + LRU cache fit in d_out");
static_assert(WS_W + W_LAYER_E * 2 * DEPTH <= WS_HB && WS_HB + (size_t)XROWS * DM * 2 <= WS_PROJ && WS_PROJ + (size_t)XROWS * DIN * 2 <= WS_END, "ws map");

constexpr int LDS_BYTES = 147456;
constexpr int NTHREADS = 512;

__device__ __forceinline__ int tidx() { int t = threadIdx.x; asm volatile("" : "+v"(t)); return t; }
__device__ __forceinline__ int bidx() { int b = __builtin_amdgcn_readfirstlane((int)blockIdx.x); asm volatile("" : "+s"(b)); return b; }
__device__ __forceinline__ float bf2f(bf16_t u) { return __uint_as_float((unsigned)u << 16); }
__device__ __forceinline__ unsigned f2bf(float f) { unsigned u = __float_as_uint(f); return (u + 0x7fffu + ((u >> 16) & 1u)) >> 16; }
__device__ __forceinline__ unsigned pk2(float lo, float hi) { return f2bf(lo) | (f2bf(hi) << 16); }
__device__ __forceinline__ float wave_sum(float v) {
#pragma unroll
    for (int o = 1; o < 64; o <<= 1) v += __shfl_xor(v, o);
    return v;
}
__device__ __forceinline__ float frcp(float x) { return __builtin_amdgcn_rcpf(x); }
__device__ __forceinline__ float fexp(float x) { return __builtin_amdgcn_exp2f(x * 1.4426950408889634f); }
__device__ __forceinline__ float sigmoidf_(float x) { return frcp(1.0f + fexp(-x)); }
__device__ __forceinline__ float gelu_tanh(float x) { const float z = 0.7978845608028654f * (x + 0.044715f * x * x * x); const float t = 1.0f - 2.0f * frcp(1.0f + fexp(2.0f * z)); return 0.5f * x * (1.0f + t); }

__device__ const double INVF[64] = {1.0, 0.8659643233600653, 0.7498942093324559, 0.6493816315762113, 0.5623413251903491, 0.4869675251658631, 0.4216965034285822, 0.3651741272548377, 0.31622776601683794, 0.27384196342643613, 0.23713737056616552, 0.2053525026457146, 0.1778279410038923, 0.1539926526059492, 0.1333521432163324, 0.11547819846894582, 0.1, 0.08659643233600653, 0.07498942093324558, 0.06493816315762113, 0.05623413251903491, 0.04869675251658631, 0.042169650342858224, 0.03651741272548377, 0.03162277660168379, 0.027384196342643614, 0.023713737056616554, 0.02053525026457146, 0.01778279410038923, 0.01539926526059492, 0.01333521432163324, 0.011547819846894581, 0.01, 0.008659643233600654, 0.007498942093324558, 0.006493816315762113, 0.005623413251903491, 0.004869675251658631, 0.004216965034285823, 0.003651741272548377, 0.0031622776601683794, 0.0027384196342643613, 0.0023713737056616554, 0.002053525026457146, 0.0017782794100389228, 0.001539926526059492, 0.001333521432163324, 0.0011547819846894581, 0.001, 0.0008659643233600654, 0.0007498942093324559, 0.0006493816315762113, 0.0005623413251903491, 0.0004869675251658631, 0.00042169650342858224, 0.0003651741272548377, 0.00031622776601683794, 0.0002738419634264361, 0.00023713737056616554, 0.0002053525026457146, 0.00017782794100389227, 0.0001539926526059492, 0.0001333521432163324, 0.00011547819846894582};

namespace pg8 {
constexpr int BM = 256, BK = 64, HALF = 128, HTB = HALF * BK * 2, STAGE_BYTES = 8 * HTB, NXCD = 8, WGM = 4;
__device__ __forceinline__ int lds_byte(int r, int c) { const int st = (r >> 4) * 2 + (c >> 5), rr = r & 15, cc = c & 31, ob = rr * 64 + cc * 2; return st * 1024 + (ob ^ (((ob >> 9) & 1) << 5)); }
__device__ __forceinline__ void stage_rc(int b, int& R, int& C) { const int st = b / 1024, sb = b % 1024, swz = sb ^ (((sb >> 9) & 1) << 5); R = (st >> 1) * 16 + swz / 64; C = (st & 1) * 32 + (swz % 64) / 2; }
__device__ __forceinline__ int perm32(int rho) { const int n = rho >> 4, i = rho & 15; return 8 * (i >> 2) + 4 * n + (i & 3); }

struct Unit { int pm, pn, idx; };
struct Gemm { const bf16_t* A; const bf16_t* Bt; int lda, N, K; };

struct StaticOrder {
    int nM, nN, nwg, G, c, wgm;
    __device__ void init(int M, int N, int G_, int c_, int wgm_ = WGM) { nM = M / BM; nN = N / BM; nwg = nM * nN; G = G_; c = c_; wgm = wgm_; }
    __device__ bool next(int i, Unit& u) const {
        const long L = (long)i * G + c; if (L >= nwg) return false;
        int wgid = (int)L; { const int q = nwg / NXCD, r = nwg % NXCD, xcd = wgid % NXCD, off = wgid / NXCD; wgid = (xcd < r ? xcd * (q + 1) : r * (q + 1) + (xcd - r) * q) + off; }
        const int nig = wgm * nN, gid = wgid / nig, fm = gid * wgm, gsz = (nM - fm) < wgm ? (nM - fm) : wgm;
        u.pm = fm + ((wgid % nig) % gsz); u.pn = (wgid % nig) / gsz; return true;
    }
};

__device__ __forceinline__ unsigned cvt_pk_bf16(float lo, float hi) { unsigned r; asm volatile("v_cvt_pk_bf16_f32 %0, %1, %2" : "=v"(r) : "v"(lo), "v"(hi)); return r; }

__device__ __forceinline__ float row_rstd(const float* ssq, int rowm) {
    const f32x4* sp = (const f32x4*)(ssq + (size_t)rowm * 16);
    const f32x4 a = sp[0], b = sp[1], c = sp[2], d = sp[3];
    const float s = ((a[0] + a[1]) + (a[2] + a[3])) + ((b[0] + b[1]) + (b[2] + b[3])) + ((c[0] + c[1]) + (c[2] + c[3])) + ((d[0] + d[1]) + (d[2] + d[3]));
    return rsqrtf(s * (1.0f / DM) + EPS);
}

constexpr int RSTD_OFF = 131072, RSTD_MAX_UNITS = 8;
__device__ __forceinline__ void fill_rstd_tables(LAS unsigned char* lds, const float* ssq, const StaticOrder& S) {
    const int tid = tidx(), row = tid & 255; const bool odd = tid >= 256;
    LAS float* tab = (LAS float*)(lds + RSTD_OFF);
    f32x4 v[RSTD_MAX_UNITS / 2][4]; bool have[RSTD_MAX_UNITS / 2];
#pragma unroll
    for (int k = 0; k < RSTD_MAX_UNITS / 2; ++k) {
        Unit ua, ub; const bool ha = S.next(2 * k, ua), hb = S.next(2 * k + 1, ub);
        have[k] = odd ? hb : ha; const int pm = odd ? ub.pm : ua.pm;
        if (have[k]) { const f32x4* sp = (const f32x4*)(ssq + (size_t)(pm * BM + row) * 16); v[k][0] = sp[0]; v[k][1] = sp[1]; v[k][2] = sp[2]; v[k][3] = sp[3]; }
    }
#pragma unroll
    for (int k = 0; k < RSTD_MAX_UNITS / 2; ++k)
        if (have[k]) { const f32x4 t = (v[k][0] + v[k][1]) + (v[k][2] + v[k][3]);
            tab[(2 * k + (odd ? 1 : 0)) * 256 + row] = rsqrtf(((t[0] + t[1]) + (t[2] + t[3])) * (1.0f / DM) + EPS); }
    __syncthreads();
}
struct EpiProj {
    static constexpr bool PERM = true;
    bf16_t* P; const LAS float* rtab; const f32x2* rope;
    __device__ __forceinline__ void operator()(const f32x4 (&acc)[2][2][4][2], const Unit& u, int wr, int wc, int fr, int fq) const {
        const bool dorope = (u.pn >= 2 && u.pn < 6);
        const __amdgpu_buffer_rsrc_t rsrc = __builtin_amdgcn_make_buffer_rsrc(P, 0, XROWS * DIN * 2, 0x00020000);
#pragma unroll
        for (int ai = 0; ai < 2; ++ai)
#pragma unroll
            for (int m = 0; m < 4; ++m) {
                const int rl = ai * HALF + wr * 64 + m * 16 + fr, rowm = u.pm * BM + rl;
                const float rs = rtab[u.idx * 256 + rl];
                bf16_t* rowp = P + (size_t)(rowX_tile(u.pm) + rl) * DIN + u.pn * BM + wc * 32 + 8 * fq;
                f32x4 cs0 = {1.f, 0.f, 1.f, 0.f}, cs1 = {1.f, 0.f, 1.f, 0.f};
                if (dorope) { const f32x4* rp = (const f32x4*)(rope + (size_t)(NMETA + (rowm & (SEQ - 1))) * 64 + 16 * wc + 4 * fq); cs0 = rp[0]; cs1 = rp[1]; }
#pragma unroll
                for (int bj = 0; bj < 2; ++bj) {
                    f32x4 v0 = acc[ai][bj][m][0] * rs, v1 = acc[ai][bj][m][1] * rs;
                    if (dorope) {
                        const f32x4 a = v0, b = v1;
                        v0[0] = a[0] * cs0[0] - a[1] * cs0[1]; v0[1] = a[0] * cs0[1] + a[1] * cs0[0];
                        v0[2] = a[2] * cs0[2] - a[3] * cs0[3]; v0[3] = a[2] * cs0[3] + a[3] * cs0[2];
                        v1[0] = b[0] * cs1[0] - b[1] * cs1[1]; v1[1] = b[0] * cs1[1] + b[1] * cs1[0];
                        v1[2] = b[2] * cs1[2] - b[3] * cs1[3]; v1[3] = b[2] * cs1[3] + b[3] * cs1[2];
                    }
                    u32x4 w; w.x = cvt_pk_bf16(v0[0], v0[1]); w.y = cvt_pk_bf16(v0[2], v0[3]); w.z = cvt_pk_bf16(v1[0], v1[1]); w.w = cvt_pk_bf16(v1[2], v1[3]);
                    __builtin_amdgcn_raw_buffer_store_b128(w, rsrc, (int)((rowp + bj * HALF - P) * 2), 0, 16);
                }
            }
    }
};
struct EpiGlu {
    static constexpr bool PERM = true;
    bf16_t* O; const LAS float* rtab;
    __device__ __forceinline__ void operator()(const f32x4 (&acc)[2][2][4][2], const Unit& u, int wr, int wc, int fr, int fq) const {
        const __amdgpu_buffer_rsrc_t rsrc = __builtin_amdgcn_make_buffer_rsrc(O, 0, XROWS * DFF * 2, 0x00020000);
#pragma unroll
        for (int ai = 0; ai < 2; ++ai)
#pragma unroll
            for (int m = 0; m < 4; ++m) {
                const int rl = ai * HALF + wr * 64 + m * 16 + fr;
                const float rs = rtab[u.idx * 256 + rl];
                bf16_t* rowp = O + (size_t)(rowX_tile(u.pm) + rl) * DFF + u.pn * HALF + wc * 32 + 8 * fq;
                float o[8];
#pragma unroll
                for (int n = 0; n < 2; ++n)
#pragma unroll
                    for (int j = 0; j < 4; ++j) { const float g = acc[ai][0][m][n][j] * rs, up = acc[ai][1][m][n][j] * rs; o[n * 4 + j] = g * up * __builtin_amdgcn_rcpf(1.0f + __builtin_amdgcn_exp2f(g * -1.4426950408889634f)); }
                u32x4 w; w.x = cvt_pk_bf16(o[0], o[1]); w.y = cvt_pk_bf16(o[2], o[3]); w.z = cvt_pk_bf16(o[4], o[5]); w.w = cvt_pk_bf16(o[6], o[7]);
                __builtin_amdgcn_raw_buffer_store_b128(w, rsrc, (int)((rowp - O) * 2), 0, 16);
            }
    }
};
struct EpiRes {
    static constexpr bool PERM = false;
    bf16_t* hb; float* ssq;
    __device__ __forceinline__ void operator()(const f32x4 (&acc)[2][2][4][2], const Unit& u, int wr, int wc, int fr, int fq) const {
#pragma unroll
        for (int ai = 0; ai < 2; ++ai) {
            u32x2 pre[4][2][2];
#pragma unroll
            for (int m = 0; m < 4; ++m) { const size_t offx = (size_t)(rowX_tile(u.pm) + ai * HALF + wr * 64 + m * 16 + fr) * DM + u.pn * BM + wc * 32 + 4 * fq;
#pragma unroll
                for (int bj = 0; bj < 2; ++bj)
#pragma unroll
                    for (int n = 0; n < 2; ++n) pre[m][bj][n] = *(const u32x2*)(hb + offx + bj * HALF + n * 16); }
#pragma unroll
            for (int m = 0; m < 4; ++m) {
                const int rl = ai * HALF + wr * 64 + m * 16 + fr, rowm = u.pm * BM + rl;
                const size_t offx = (size_t)(rowX_tile(u.pm) + rl) * DM + u.pn * BM + wc * 32 + 4 * fq;
                float ss = 0.f;
#pragma unroll
                for (int bj = 0; bj < 2; ++bj)
#pragma unroll
                    for (int n = 0; n < 2; ++n) {
                        const u32x2 p = pre[m][bj][n];
                        const f32x4 v = (f32x4){__uint_as_float(p.x << 16), __uint_as_float(p.x & 0xffff0000u), __uint_as_float(p.y << 16), __uint_as_float(p.y & 0xffff0000u)} + acc[ai][bj][m][n];
                        u32x2 w; w.x = cvt_pk_bf16(v[0], v[1]); w.y = cvt_pk_bf16(v[2], v[3]);
                        *(u32x2*)(hb + offx + bj * HALF + n * 16) = w;
                        const float r0 = __uint_as_float(w.x << 16), r1 = __uint_as_float(w.x & 0xffff0000u), r2 = __uint_as_float(w.y << 16), r3 = __uint_as_float(w.y & 0xffff0000u);
                        ss += (r0 * r0 + r1 * r1) + (r2 * r2 + r3 * r3);
                    }
                ss += __shfl_xor(ss, 16); ss += __shfl_xor(ss, 32);
                if (fq == 0) ssq[(size_t)rowm * 16 + u.pn * 4 + wc] = ss;
            }
        }
    }
};
struct EpiDry {
    static constexpr bool PERM = false;
    float* sink;
    __device__ __forceinline__ void operator()(const f32x4 (&acc)[2][2][4][2], const Unit& u, int wr, int wc, int fr, int fq) const {
        f32x4 t = {0.f, 0.f, 0.f, 0.f};
#pragma unroll
        for (int ai = 0; ai < 2; ++ai)
#pragma unroll
            for (int bj = 0; bj < 2; ++bj)
#pragma unroll
                for (int m = 0; m < 4; ++m)
#pragma unroll
                    for (int n = 0; n < 2; ++n) t += acc[ai][bj][m][n];
        if (t[0] + t[1] + t[2] + t[3] == 1.2345e30f) sink[0] = t[0];
    }
};
template <class Epi, bool ALIGN_EPI, bool SP2>
__device__ __forceinline__ void gemm_phase(LAS unsigned char* lds, const Gemm g, const StaticOrder& S, const Epi& E) {
    const int tid = tidx(), wid = __builtin_amdgcn_readfirstlane(tid >> 6), lane = tid & 63, wr = wid >> 2, wc = wid & 3, fr = lane & 15, fq = lane >> 4;
    const int K = g.K, nt = K / BK, lda = g.lda;
    unsigned voffA[2], voffB[2];
#pragma unroll
    for (int i = 0; i < 2; ++i) { int R, C; stage_rc(tid * 16 + i * 8192, R, C); const int Rb = Epi::PERM ? ((R & ~31) + perm32(R & 31)) : R;
        voffA[i] = (unsigned)(R * lda + C) * 2u; voffB[i] = (unsigned)(Rb * K + C) * 2u; }
    const size_t kstep = (size_t)(BK * 2);
    const size_t hstepA = (size_t)HALF * lda * 2, hstepB = (size_t)HALF * K * 2;
    const size_t tstepB = 2 * hstepB;
    const unsigned ldsw = (unsigned)wid * 1024u;
    const int aoff = lds_byte(wr * 64 + fr, fq * 8), boff = lds_byte(wc * 32 + fr, fq * 8);
#define PG8_SA(b, h) (((b) * 2 + (h)) * HTB)
#define PG8_SB(b, h) ((4 + (b) * 2 + (h)) * HTB)
#define PG8_STAGE(bufoff, gbase, voff) do { _Pragma("unroll") for (int _i = 0; _i < 2; ++_i) \
        __builtin_amdgcn_global_load_lds((const unsigned*)((const char*)(gbase) + (voff)[_i]), (LAS unsigned*)(lds + (bufoff) + ldsw + _i * 8192), 16, 0, 0); } while (0)
#define PG8_LDA(dst, b, h) do { _Pragma("unroll") for (int m = 0; m < 4; ++m) _Pragma("unroll") for (int k = 0; k < 2; ++k) dst[m][k] = *(const LAS bf16x8*)(lds + PG8_SA(b, h) + aoff + m * 2048 + k * 1024); } while (0)
#define PG8_LDB(dst, b, h) do { _Pragma("unroll") for (int n = 0; n < 2; ++n) _Pragma("unroll") for (int k = 0; k < 2; ++k) dst[n][k] = *(const LAS bf16x8*)(lds + PG8_SB(b, h) + boff + n * 2048 + k * 1024); } while (0)
#define PG8_MMA(ai, bj, At, Bt) do { __builtin_amdgcn_s_setprio(1); _Pragma("unroll") for (int m = 0; m < 4; ++m) _Pragma("unroll") for (int n = 0; n < 2; ++n) _Pragma("unroll") for (int k = 0; k < 2; ++k) \
        acc[ai][bj][m][n] = __builtin_amdgcn_mfma_f32_16x16x32_bf16(Bt[n][k], At[m][k], acc[ai][bj][m][n], 0, 0, 0); __builtin_amdgcn_s_setprio(0); } while (0)
#define PG8_WAIT_V(n) asm volatile("s_waitcnt vmcnt(" #n ")" ::: "memory")
#define PG8_WAIT_L(n) asm volatile("s_waitcnt lgkmcnt(" #n ")" ::: "memory")
#define PG8_BAR __builtin_amdgcn_s_barrier()
#define PG8_SCHED __builtin_amdgcn_sched_barrier(0)
    Unit cur, nxt; int ui = 0;
    if (!S.next(0, cur)) return;
    cur.idx = 0;
    f32x4 acc[2][2][4][2];
#pragma unroll
    for (int a = 0; a < 2; ++a)
#pragma unroll
        for (int b = 0; b < 2; ++b)
#pragma unroll
            for (int m = 0; m < 4; ++m)
#pragma unroll
                for (int n = 0; n < 2; ++n) acc[a][b][m][n] = (f32x4){0.f, 0.f, 0.f, 0.f};
    bf16x8 At[4][2], B0[2][2], B1[2][2];
    const char* cA = (const char*)g.A + (size_t)rowX_tile(cur.pm) * lda * 2; const char* cB = (const char*)g.Bt + (size_t)cur.pn * tstepB;
    if constexpr (SP2) {
        PG8_STAGE(PG8_SB(0, 0), cB, voffB); PG8_STAGE(PG8_SB(0, 1), cB + hstepB, voffB); PG8_STAGE(PG8_SA(0, 0), cA, voffA); PG8_STAGE(PG8_SA(0, 1), cA + hstepA, voffA);
        if (wr == 1) PG8_BAR;
        PG8_WAIT_V(2); PG8_BAR;
        PG8_STAGE(PG8_SB(1, 0), cB + kstep, voffB); PG8_STAGE(PG8_SA(1, 0), cA + kstep, voffA); PG8_STAGE(PG8_SB(1, 1), cB + hstepB + kstep, voffB);
        PG8_WAIT_V(6); PG8_BAR;
    } else {
        PG8_STAGE(PG8_SB(0, 0), cB, voffB); PG8_STAGE(PG8_SA(0, 0), cA, voffA); PG8_STAGE(PG8_SB(0, 1), cB + hstepB, voffB); PG8_STAGE(PG8_SA(0, 1), cA + hstepA, voffA);
        if (wr == 1) PG8_BAR;
        PG8_WAIT_V(4); PG8_BAR;
        PG8_STAGE(PG8_SB(1, 0), cB + kstep, voffB); PG8_STAGE(PG8_SA(1, 0), cA + kstep, voffA); PG8_STAGE(PG8_SB(1, 1), cB + hstepB + kstep, voffB);
        PG8_WAIT_V(6); PG8_BAR;
    }
    for (;;) {
        const bool has_next = S.next(ui + 1, nxt); nxt.idx = ui + 1;
        const char* nA = has_next ? (const char*)g.A + (size_t)rowX_tile(nxt.pm) * lda * 2 : cA; const char* nB = has_next ? (const char*)g.Bt + (size_t)nxt.pn * tstepB : cB;
        for (int t = 0; t < nt; t += 2) {
            const bool last = (t == nt - 2);
            const char* a1 = cA + (size_t)(t + 1) * kstep;
            const char* a2 = last ? nA : cA + (size_t)(t + 2) * kstep; const char* b2 = last ? nB : cB + (size_t)(t + 2) * kstep;
            const char* a3 = a2 + kstep; const char* b3 = b2 + kstep;
            if constexpr (SP2) {
            PG8_LDB(B0, 0, 0); PG8_LDB(B1, 0, 1); PG8_SCHED; PG8_LDA(At, 0, 0); PG8_STAGE(PG8_SA(1, 1), a1 + hstepA, voffA);
            PG8_WAIT_V(8); PG8_WAIT_L(0); PG8_BAR; PG8_MMA(0, 0, At, B0); PG8_MMA(0, 1, At, B1); PG8_BAR; PG8_SCHED;
            PG8_LDA(At, 0, 1); PG8_STAGE(PG8_SB(0, 0), b2, voffB); PG8_STAGE(PG8_SB(0, 1), b2 + hstepB, voffB); PG8_STAGE(PG8_SA(0, 0), a2, voffA);
            PG8_WAIT_V(8); PG8_WAIT_L(0); PG8_BAR; PG8_MMA(1, 0, At, B0); PG8_MMA(1, 1, At, B1); PG8_BAR; PG8_SCHED;
            PG8_LDB(B0, 1, 0); PG8_LDB(B1, 1, 1); PG8_SCHED; PG8_LDA(At, 1, 0); PG8_STAGE(PG8_SA(0, 1), a2 + hstepA, voffA);
            PG8_WAIT_V(8); PG8_WAIT_L(0); PG8_BAR; PG8_MMA(0, 0, At, B0); PG8_MMA(0, 1, At, B1); PG8_BAR; PG8_SCHED;
            PG8_LDA(At, 1, 1); PG8_STAGE(PG8_SB(1, 0), b3, voffB); PG8_STAGE(PG8_SB(1, 1), b3 + hstepB, voffB); PG8_STAGE(PG8_SA(1, 0), a3, voffA);
            PG8_WAIT_V(8); PG8_WAIT_L(0); PG8_BAR; PG8_MMA(1, 0, At, B0); PG8_MMA(1, 1, At, B1); PG8_BAR; PG8_SCHED;
            } else {
            PG8_LDB(B0, 0, 0); PG8_SCHED; PG8_LDA(At, 0, 0); PG8_STAGE(PG8_SA(1, 1), a1 + hstepA, voffA);
            PG8_WAIT_L(8); PG8_BAR; PG8_WAIT_L(0); PG8_MMA(0, 0, At, B0); PG8_BAR; PG8_SCHED;
            PG8_LDB(B1, 0, 1); PG8_STAGE(PG8_SB(0, 0), b2, voffB);
            PG8_BAR; PG8_WAIT_L(0); PG8_MMA(0, 1, At, B1); PG8_BAR;
            PG8_LDA(At, 0, 1); PG8_STAGE(PG8_SA(0, 0), a2, voffA);
            PG8_BAR; PG8_WAIT_L(0); PG8_MMA(1, 0, At, B0); PG8_BAR; PG8_SCHED;
            PG8_STAGE(PG8_SB(0, 1), b2 + hstepB, voffB);
            PG8_WAIT_V(6); PG8_BAR; PG8_MMA(1, 1, At, B1); PG8_BAR;
            PG8_LDB(B0, 1, 0); PG8_SCHED; PG8_LDA(At, 1, 0); PG8_STAGE(PG8_SA(0, 1), a2 + hstepA, voffA);
            PG8_WAIT_L(8); PG8_BAR; PG8_WAIT_L(0); PG8_MMA(0, 0, At, B0); PG8_BAR; PG8_SCHED;
            PG8_LDB(B1, 1, 1); PG8_STAGE(PG8_SB(1, 0), b3, voffB);
            PG8_BAR; PG8_WAIT_L(0); PG8_MMA(0, 1, At, B1); PG8_BAR;
            PG8_LDA(At, 1, 1); PG8_STAGE(PG8_SA(1, 0), a3, voffA);
            PG8_BAR; PG8_WAIT_L(0); PG8_MMA(1, 0, At, B0); PG8_BAR; PG8_SCHED;
            PG8_STAGE(PG8_SB(1, 1), b3 + hstepB, voffB);
            PG8_WAIT_V(6); PG8_BAR; PG8_MMA(1, 1, At, B1); PG8_BAR;
            }
        }
        if constexpr (ALIGN_EPI) { if (wr == 0) PG8_BAR; }
        E(acc, cur, wr, wc, fr, fq);
        if (!has_next) break;
#pragma unroll
        for (int a = 0; a < 2; ++a)
#pragma unroll
            for (int b = 0; b < 2; ++b)
#pragma unroll
                for (int m = 0; m < 4; ++m)
#pragma unroll
                    for (int n = 0; n < 2; ++n) acc[a][b][m][n] = (f32x4){0.f, 0.f, 0.f, 0.f};
        cur = nxt; cA = nA; cB = nB; ++ui;
        if constexpr (ALIGN_EPI) { if (wr == 1) PG8_BAR; }
    }
    PG8_WAIT_V(0);
    if constexpr (!ALIGN_EPI) { if (wr == 0) PG8_BAR; }
    PG8_BAR;
#undef PG8_SA
#undef PG8_SB
#undef PG8_STAGE
#undef PG8_LDA
#undef PG8_LDB
#undef PG8_MMA
#undef PG8_WAIT_V
#undef PG8_WAIT_L
#undef PG8_BAR
#undef PG8_SCHED
}
}

#define XB_TMO      128
#define XB_XCNT(j)  (256  + 64 * (j))
#define XB_XSUB(j)  (1280 + 64 * (j))
#define XB_XGEN(j)  (2304 + 64 * (j))
#define XB_TOP      3328
#define XB_TOPGEN   3392
#define XCD_BAR_WORDS 3456
#define XB_SPIN_CAP (1u << 18)

__device__ __forceinline__ unsigned xb_ld(unsigned* p)              { return __hip_atomic_load(p, __ATOMIC_RELAXED, __HIP_MEMORY_SCOPE_AGENT); }
__device__ __forceinline__ unsigned xb_add(unsigned* p, unsigned v) { return __hip_atomic_fetch_add(p, v, __ATOMIC_RELAXED, __HIP_MEMORY_SCOPE_AGENT); }
__device__ __forceinline__ unsigned xb_xcc_id() { return (unsigned)__builtin_amdgcn_s_getreg((3 << 11) | 20) & 0xFu; }
#define XB_SPIN(cond, bar) do { unsigned _sp = 0; while (cond) { \
    if ((++_sp & 255u) == 0u) { if (xb_ld(&(bar)[XB_TMO])) break; if (_sp > XB_SPIN_CAP) { atomicAdd(&(bar)[XB_TMO], 1u); break; } } } } while (0)

struct XcdBarrier {
    unsigned* bar; unsigned x;
    volatile LAS unsigned* st;
};

__device__ __forceinline__ XcdBarrier xcd_barrier_post(unsigned* bar, volatile LAS unsigned* st) {
    XcdBarrier b; b.bar = bar; b.x = xb_xcc_id(); b.st = st;
    if (threadIdx.x == 0) (void)xb_add(&bar[XB_XCNT(b.x)], 1u);
    return b;
}
__device__ __forceinline__ void xcd_barrier_complete(unsigned* bar, unsigned x, unsigned& nloc, unsigned& nx) {
    const unsigned G = gridDim.x * gridDim.y * gridDim.z;
    unsigned sum, cnt, mine, sp = 0u;
    for (;;) {
        sum = 0u; cnt = 0u; mine = 0u;
#pragma unroll
        for (unsigned j = 0; j < 16; ++j) { const unsigned c = xb_ld(&bar[XB_XCNT(j)]); sum += c; cnt += (c > 0u) ? 1u : 0u; mine = (j == x) ? c : mine; }
        if (sum == G) break;
        __builtin_amdgcn_s_sleep(1);
        if ((++sp & 255u) == 0u) { if (xb_ld(&bar[XB_TMO])) break; if (sp > XB_SPIN_CAP) { atomicAdd(&bar[XB_TMO], 1u); break; } }
    }
    nloc = mine > 0u ? mine : 1u; nx = cnt > 0u ? cnt : 1u;
}

__device__ __forceinline__ void xcd_barrier(const XcdBarrier& b) {
    asm volatile("s_waitcnt vmcnt(0)" ::: "memory");
    __syncthreads();
    if (threadIdx.x == 0) {
        unsigned* bar = b.bar;
        __builtin_amdgcn_s_waitcnt(0);
        unsigned nloc = b.st[0], nx = b.st[1];
        if (nloc == 0u) { xcd_barrier_complete(bar, b.x, nloc, nx); b.st[0] = nloc; b.st[1] = nx; }
        const unsigned old = xb_add(&bar[XB_XSUB(b.x)], 1u);
        const unsigned gen = old / nloc;
        if (old + 1u == (gen + 1u) * nloc) {
            __builtin_amdgcn_fence(__ATOMIC_RELEASE, "agent");
            asm volatile("s_waitcnt vmcnt(0)" ::: "memory");
            const unsigned og = xb_add(&bar[XB_TOP], 1u);
            const unsigned tg = og / nx;
            if (og + 1u == (tg + 1u) * nx) xb_add(&bar[XB_TOPGEN], 1u);
            else XB_SPIN(xb_ld(&bar[XB_TOPGEN]) == tg, bar);
            __builtin_amdgcn_fence(__ATOMIC_ACQUIRE, "agent");
            xb_add(&bar[XB_XGEN(b.x)], 1u);
            asm volatile("s_waitcnt vmcnt(0)" ::: "memory");
        } else {
            XB_SPIN(xb_ld(&bar[XB_XGEN(b.x)]) == gen, bar);
            __builtin_amdgcn_fence(__ATOMIC_ACQUIRE, "agent");
            asm volatile("s_waitcnt vmcnt(0)" ::: "memory");
        }
    }
    __syncthreads();
}


struct Args { const float* in[19]; float* out; unsigned char* ws; int ph_lo, ph_hi; };
typedef const __attribute__((address_space(4))) Args* CArgsP;
__device__ __forceinline__ CArgsP kargs() { CArgsP p = (CArgsP)__builtin_amdgcn_kernarg_segment_ptr(); asm volatile("" : "+s"(p)); return p; }
#define KA (kargs())
enum { I_X = 0, I_META, I_NMIX, I_WIN, I_CONVW, I_CONVB, I_GAW, I_GAB, I_GXW, I_GXB, I_LAM, I_LRUN, I_RETN, I_WOUT, I_NFFN, I_WG, I_WU, I_WD, I_NFIN };

#define LDS_WAIT() asm volatile("s_waitcnt lgkmcnt(0)" ::: "memory")

struct TrDesc { const float* W; const float* gain; bf16_t* WT; int K, N, kind, k0, n0; };
__device__ __forceinline__ TrDesc tr_desc(int it) {
    constexpr int I_IN = (DM / 64) * (DIN / 32), I_OUT = (DM / 64) * (DM / 32), I_G = (DM / 64) * (DFF / 32);
    constexpr int PER_LAYER = I_IN + I_OUT + 2 * I_G + (DFF / 64) * (DM / 32);
    const int l = it / PER_LAYER; int r = it % PER_LAYER;
    bf16_t* wl = (bf16_t*)(KA->ws + WS_W) + (size_t)l * W_LAYER_E;
    TrDesc d;
    if (r < I_IN) { d.W = KA->in[I_WIN] + (size_t)l * DM * DIN; d.gain = KA->in[I_NMIX] + l * DM; d.WT = wl; d.K = DM; d.N = DIN; d.kind = 0; }
    else if ((r -= I_IN) < I_OUT) { d.W = KA->in[I_WOUT] + (size_t)l * DM * DM; d.gain = nullptr; d.WT = wl + W_IN_E; d.K = DM; d.N = DM; d.kind = 1; }
    else if ((r -= I_OUT) < I_G) { d.W = KA->in[I_WG] + (size_t)l * DM * DFF; d.gain = KA->in[I_NFFN] + l * DM; d.WT = wl + W_IN_E + W_OUT_E; d.K = DM; d.N = DFF; d.kind = 2; }
    else if ((r -= I_G) < I_G) { d.W = KA->in[I_WU] + (size_t)l * DM * DFF; d.gain = KA->in[I_NFFN] + l * DM; d.WT = wl + W_IN_E + W_OUT_E; d.K = DM; d.N = DFF; d.kind = 3; }
    else { r -= I_G; d.W = KA->in[I_WD] + (size_t)l * DFF * DM; d.gain = nullptr; d.WT = wl + W_IN_E + W_OUT_E + W_GU_E; d.K = DFF; d.N = DM; d.kind = 1; }
    const int nblk = d.N / 32; d.k0 = 64 * (r / nblk); d.n0 = 32 * (r % nblk);
    return d;
}
__device__ __forceinline__ void tr_load(const TrDesc& d, float (&v)[32], int lane) {
    const float* wp = d.W + (size_t)(d.k0 + (lane >> 5)) * d.N + d.n0 + (lane & 31);
#pragma unroll
    for (int i = 0; i < 32; ++i) v[i] = wp[(size_t)(2 * i) * d.N];
}
__device__ __forceinline__ void tr_emit(const TrDesc& d, const float (&v)[32], LAS float* scr, int lane) {
    const int c = lane & 7;
    f32x4 g0 = {1.f, 1.f, 1.f, 1.f}, g1 = {1.f, 1.f, 1.f, 1.f};
    if (d.gain) { g0 = *(const f32x4*)(d.gain + d.k0 + 8 * c); g1 = *(const f32x4*)(d.gain + d.k0 + 8 * c + 4); }
#pragma unroll
    for (int i = 0; i < 32; ++i) scr[(2 * i + (lane >> 5)) * 33 + (lane & 31)] = v[i];
    LDS_WAIT(); asm volatile("" ::: "memory");
#pragma unroll
    for (int j = 0; j < 4; ++j) {
        const int n = (lane >> 3) + 8 * j, ncol = d.n0 + n; int dest = ncol; float sc = 1.0f;
        if (d.kind == 0) { const int reg = ncol >> 9, r = ncol & 511, hh = r >> 7, dd = r & 127, p = 2 * (dd & 63) + (dd >> 6);
            if (reg == 0) dest = C_XL + r; else if (reg == 1) dest = C_GL + r; else if (reg == 2) dest = C_Q + 128 * hh + p;
            else if (reg == 3) { dest = C_K + 128 * hh + p; sc = 0.08838834764831845f; } else if (reg == 4) dest = C_V + r; else dest = C_GR + r; }
        else if (d.kind == 2) dest = (ncol >> 7) * 256 + (ncol & 127);
        else if (d.kind == 3) dest = (ncol >> 7) * 256 + 128 + (ncol & 127);
        const LAS float* s = scr + (8 * c) * 33 + n;
        u32x4 o; o.x = pk2(s[0 * 33] * (g0[0] * sc), s[1 * 33] * (g0[1] * sc)); o.y = pk2(s[2 * 33] * (g0[2] * sc), s[3 * 33] * (g0[3] * sc));
        o.z = pk2(s[4 * 33] * (g1[0] * sc), s[5 * 33] * (g1[1] * sc)); o.w = pk2(s[6 * 33] * (g1[2] * sc), s[7 * 33] * (g1[3] * sc));
        *(u32x4*)(d.WT + (size_t)dest * d.K + d.k0 + 8 * c) = o;
    }
    LDS_WAIT(); asm volatile("" ::: "memory");
}

__device__ __forceinline__ void prologue(LAS unsigned char* lds, int G) {
    const int tid = tidx(), lane = tid & 63, wave = __builtin_amdgcn_readfirstlane(tid >> 6);
    LAS float* scr = (LAS float*)(lds + wave * 16384);
    const int gw = bidx() * 8 + wave, NGW = G * 8;
    {
        constexpr int TOTAL = ((DM / 64) * (DIN / 32) + (DM / 64) * (DM / 32) + 2 * (DM / 64) * (DFF / 32) + (DFF / 64) * (DM / 32)) * DEPTH;
        float va[32], vb[32]; TrDesc da, db;
        int it = gw;
        if (it < TOTAL) { da = tr_desc(it); tr_load(da, va, lane); }
        while (it < TOTAL) {
            int nx = it + NGW;
            if (nx < TOTAL) { db = tr_desc(nx); tr_load(db, vb, lane); }
            tr_emit(da, va, scr, lane);
            it = nx; nx = it + NGW;
            if (it < TOTAL) { if (nx < TOTAL) { da = tr_desc(nx); tr_load(da, va, lane); } tr_emit(db, vb, scr, lane); it = nx; }
        }
    }
    const float* x = KA->in[I_X]; bf16_t* HB = (bf16_t*)(KA->ws + WS_HB); float* ssq = (float*)(KA->ws + WS_SSQ);
    for (int m0 = gw; m0 < MROWS; m0 += 2 * NGW) {
        f32x4 v[2][4];
#pragma unroll
        for (int q = 0; q < 2; ++q) { const int m = m0 + q * NGW; if (m < MROWS) { const f32x4* xr = (const f32x4*)(x + (size_t)m * DM) + lane;
#pragma unroll
            for (int j = 0; j < 4; ++j) v[q][j] = xr[64 * j]; } }
#pragma unroll
        for (int q = 0; q < 2; ++q) { const int m = m0 + q * NGW; if (m < MROWS) {
            float s = 0.f;
#pragma unroll
            for (int j = 0; j < 4; ++j) s += (v[q][j][0] * v[q][j][0] + v[q][j][1] * v[q][j][1]) + (v[q][j][2] * v[q][j][2] + v[q][j][3] * v[q][j][3]);
            s = wave_sum(s);
            u32x2* o = (u32x2*)(HB + (size_t)rowX(m) * DM) + lane;
#pragma unroll
            for (int j = 0; j < 4; ++j) { u32x2 w; w.x = pk2(v[q][j][0], v[q][j][1]); w.y = pk2(v[q][j][2], v[q][j][3]); o[64 * j] = w; }
            if (lane < 16) ssq[(size_t)m * 16 + lane] = (lane == 0) ? s : 0.f; } }
    }
    const int gt = bidx() * NTHREADS + tid, NGT = G * NTHREADS;
    f32x2* rope = (f32x2*)(KA->ws + WS_ROPE);
    for (int i = gt; i < TT * 64; i += NGT) {
        const int pos = i >> 6, f = i & 63;
        const double rev = (double)pos * INVF[f] * 0.15915494309189535;
        const float fr = (float)(rev - floor(rev));
        rope[i] = (f32x2){__builtin_amdgcn_cosf(fr), __builtin_amdgcn_sinf(fr)};
    }
    { bf16_t* wax = (bf16_t*)(KA->ws + WS_WAX);
      for (int i = gt; i < DEPTH * 8 * 2 * 64 * 64; i += NGT) { const int ii = i & 63, j = (i >> 6) & 63, which = (i >> 12) & 1, lg8 = i >> 13;
          const float* src = which ? KA->in[I_GXW] : KA->in[I_GAW]; wax[i] = (bf16_t)f2bf(-1.4426950408889634f * src[((size_t)lg8 * 64 + ii) * 64 + j]); } }
    float* HM = (float*)(KA->ws + WS_HM);
    for (int i = gt; i < NMETA * DM; i += NGT) HM[i] = KA->in[I_META][i];
}

template <int MODE, int K>
__device__ __forceinline__ void skinny_item(LAS unsigned char* lds, int item, const float* HMr, const bf16_t* Abf, int lda, const bf16_t* Bt, float* HMw, bf16_t* Obf, const f32x2* rope) {
    const int tid = tidx(), lane = tid & 63, wave = __builtin_amdgcn_readfirstlane(tid >> 6), fr = lane & 15, fq = lane >> 4;
    const int n0 = item * 16;
    int brow = n0 + fr; if (MODE == 2) brow = (n0 >> 7) * 256 + (n0 & 127) + fr;
    constexpr int kper = K / 8, KSTEPS = kper / 32; const int kbeg = wave * kper;
    f32x4 acc = {0.f, 0.f, 0.f, 0.f}, acc2 = {0.f, 0.f, 0.f, 0.f}; float ss = 0.f;
    const int colE = n0 + 4 * fq;
    f32x4 hmv = {0.f, 0.f, 0.f, 0.f}; f32x2 rc0 = {1.f, 0.f}, rc1 = {1.f, 0.f};
    if (MODE == 1) hmv = *(const f32x4*)(HMw + (size_t)fr * DM + colE);
    if (MODE == 0 && colE >= C_Q && colE < C_GL) { const int i0 = (colE & 127) >> 1; rc0 = rope[fr * 64 + i0]; rc1 = rope[fr * 64 + i0 + 1]; }
    bf16x8 bq[KSTEPS], bq2[KSTEPS], aq[KSTEPS]; f32x4 au[KSTEPS], av[KSTEPS];
#pragma unroll
    for (int st = 0; st < KSTEPS; ++st) { const int k0 = kbeg + 32 * st;
        if (MODE == 1) aq[st] = *(const bf16x8*)(Abf + (size_t)fr * lda + k0 + 8 * fq);
        else { const f32x4* p = (const f32x4*)(HMr + (size_t)fr * DM + k0 + 8 * fq); au[st] = p[0]; av[st] = p[1]; }
        bq[st] = *(const bf16x8*)(Bt + (size_t)brow * K + k0 + 8 * fq);
        if (MODE == 2) bq2[st] = *(const bf16x8*)(Bt + (size_t)(brow + 128) * K + k0 + 8 * fq); }
    __builtin_amdgcn_sched_barrier(0);
#pragma unroll
    for (int st = 0; st < KSTEPS; ++st) {
        bf16x8 af;
        if (MODE == 1) af = aq[st];
        else { const f32x4 u = au[st], v = av[st];
            ss += (u[0] * u[0] + u[1] * u[1]) + (u[2] * u[2] + u[3] * u[3]) + (v[0] * v[0] + v[1] * v[1]) + (v[2] * v[2] + v[3] * v[3]);
            u32x4 w; w.x = pk2(u[0], u[1]); w.y = pk2(u[2], u[3]); w.z = pk2(v[0], v[1]); w.w = pk2(v[2], v[3]); af = __builtin_bit_cast(bf16x8, w); }
        acc = __builtin_amdgcn_mfma_f32_16x16x32_bf16(bq[st], af, acc, 0, 0, 0);
        if (MODE == 2) acc2 = __builtin_amdgcn_mfma_f32_16x16x32_bf16(bq2[st], af, acc2, 0, 0, 0);
    }
    ss += __shfl_xor(ss, 16); ss += __shfl_xor(ss, 32);
    LAS float* red = (LAS float*)lds;
    LAS float* mine = red + (wave * 64 + lane) * 9;
    mine[0] = acc[0]; mine[1] = acc[1]; mine[2] = acc[2]; mine[3] = acc[3]; mine[4] = acc2[0]; mine[5] = acc2[1]; mine[6] = acc2[2]; mine[7] = acc2[3]; mine[8] = ss;
    __syncthreads();
    if (wave == 0) {
        float r[9];
#pragma unroll
        for (int q = 0; q < 9; ++q) { float s = 0.f;
#pragma unroll
            for (int w = 0; w < 8; ++w) s += red[(w * 64 + lane) * 9 + q]; r[q] = s; }
        const float rs = rsqrtf(r[8] * (1.0f / DM) + EPS);
        const int col = n0 + 4 * fq;
        if (MODE == 0) {
            float v0 = r[0] * rs, v1 = r[1] * rs, v2 = r[2] * rs, v3 = r[3] * rs;
            if (col >= C_Q && col < C_GL) { const f32x2 c0 = rc0, c1 = rc1;
                const float a0 = v0, a1 = v1, a2 = v2, a3 = v3; v0 = a0 * c0[0] - a1 * c0[1]; v1 = a0 * c0[1] + a1 * c0[0]; v2 = a2 * c1[0] - a3 * c1[1]; v3 = a2 * c1[1] + a3 * c1[0]; }
            u32x2 w; w.x = pk2(v0, v1); w.y = pk2(v2, v3);
#pragma unroll
            for (int b = 0; b < NB; ++b) *(u32x2*)(Obf + (size_t)(b * TT + fr) * DIN + col) = w;
        } else if (MODE == 1) {
            f32x4* p = (f32x4*)(HMw + (size_t)fr * DM + col); f32x4 v = hmv; v[0] += r[0]; v[1] += r[1]; v[2] += r[2]; v[3] += r[3]; *p = v;
        } else {
            float o[4];
#pragma unroll
            for (int j = 0; j < 4; ++j) { const float g = r[j] * rs, up = r[4 + j] * rs; o[j] = g * up * __builtin_amdgcn_rcpf(1.0f + __builtin_amdgcn_exp2f(g * -1.4426950408889634f)); }
            u32x2 w; w.x = pk2(o[0], o[1]); w.y = pk2(o[2], o[3]);
            *(u32x2*)(Obf + (size_t)fr * DFF + col) = w;
        }
    }
    __syncthreads();
}

constexpr int XS = 516;
constexpr int TS = 140;
constexpr int SS = 136;
__device__ __forceinline__ bf16x8 ld_lds_2x8(const LAS bf16_t* p0, const LAS bf16_t* p1) { const u32x2 a = *(const LAS u32x2*)p0, b = *(const LAS u32x2*)p1; u32x4 w; w.x = a.x; w.y = a.y; w.z = b.x; w.w = b.y; return __builtin_bit_cast(bf16x8, w); }
__device__ __forceinline__ f32x4 mfma16(bf16x8 a, bf16x8 b, f32x4 c) { return __builtin_amdgcn_mfma_f32_16x16x32_bf16(a, b, c, 0, 0, 0); }

__device__ __forceinline__ u32x4* lc_item(int b, int c, int g, int nt, int mt, int lane) {
    unsigned char* base = (unsigned char*)KA->out + 16 * MiB + (size_t)b * LC_BATCH;
    return (u32x4*)base + ((((size_t)c * 8 + g) * 4 + nt) * 4 + mt) * 64 + lane;
}
__device__ __forceinline__ void lru_unit(LAS unsigned char* lds, int l, int b, int c, bool full, bool nostore = false, bool ldsc = false) {
    const int tid = tidx(), lane = tid & 63, wave = __builtin_amdgcn_readfirstlane(tid >> 6), fr = lane & 15, fq = lane >> 4;
    const int t0 = c == 0 ? 0 : NMETA + 64 * (c - 1), ntok = c == 0 ? NMETA : 64, nmt = ntok >> 4;
    LAS float* xcL = (LAS float*)lds;
    LAS float* part = xcL + 64 * XS;
    bf16_t* P = (bf16_t*)(KA->ws + WS_PROJ) + (size_t)b * TT * DIN;
    bf16x8 wfr[4][4]; float bav[4], bxv[4], c2v[4];
    if (!full) {
        const bf16_t* wt0 = (const bf16_t*)(KA->ws + WS_WAX) + (size_t)(l * 8 + wave) * 2 * 64 * 64;
#pragma unroll
        for (int nt = 0; nt < 4; ++nt) {
            const bf16_t* wr = wt0 + (size_t)(16 * nt + fr) * 64 + 8 * fq;
            wfr[nt][0] = *(const bf16x8*)wr; wfr[nt][1] = *(const bf16x8*)(wr + 32); wfr[nt][2] = *(const bf16x8*)(wr + 64 * 64); wfr[nt][3] = *(const bf16x8*)(wr + 64 * 64 + 32);
            const int chn = l * DLRU + 64 * wave + 16 * nt + fr;
            bav[nt] = -1.4426950408889634f * KA->in[I_GAB][chn]; bxv[nt] = -1.4426950408889634f * KA->in[I_GXB][chn];
            c2v[nt] = -8.0f * 1.4426950408889634f * log1pf(__expf(-KA->in[I_LAM][chn]));
        }
    }
    u32x4 gr[8]; f32x4 og0 = {0.f, 0.f, 0.f, 0.f}, og1 = {0.f, 0.f, 0.f, 0.f};
    if (full && 8 * wave < ntok) {
#pragma unroll
        for (int i = 0; i < 8; ++i) gr[i] = *(const u32x4*)(P + (size_t)(t0 + 8 * wave + i) * DIN + C_GL + 8 * lane);
        const float* ogp = KA->in[I_LRUN] + l * DLRU + 8 * lane; og0 = *(const f32x4*)ogp; og1 = *(const f32x4*)(ogp + 4);
    }
    if (!full) {
        const int tb = 8 * wave, cb8 = 8 * lane;
        if (tb < ntok) {
            u32x4 xr[11];
#pragma unroll
            for (int i = 0; i < 11; ++i) { const int t = t0 + tb + i - 3; xr[i] = (u32x4){0u, 0u, 0u, 0u}; if (t >= 0) xr[i] = *(const u32x4*)(P + (size_t)t * DIN + C_XL + cb8); }
            const float* cw = KA->in[I_CONVW] + (size_t)l * 4 * DLRU + cb8; const float* cbp = KA->in[I_CONVB] + l * DLRU + cb8;
            f32x4 wv[4][2], cbv[2];
#pragma unroll
            for (int k = 0; k < 4; ++k) { wv[k][0] = *(const f32x4*)(cw + k * DLRU); wv[k][1] = *(const f32x4*)(cw + k * DLRU + 4); }
            cbv[0] = *(const f32x4*)cbp; cbv[1] = *(const f32x4*)(cbp + 4);
#pragma unroll
            for (int i = 0; i < 8; ++i) {
                f32x4 o0 = cbv[0], o1 = cbv[1];
#pragma unroll
                for (int k = 0; k < 4; ++k) { const u32x4 w = xr[i + k];
                    const f32x4 a0 = {__uint_as_float(w.x << 16), __uint_as_float(w.x & 0xffff0000u), __uint_as_float(w.y << 16), __uint_as_float(w.y & 0xffff0000u)};
                    const f32x4 a1 = {__uint_as_float(w.z << 16), __uint_as_float(w.z & 0xffff0000u), __uint_as_float(w.w << 16), __uint_as_float(w.w & 0xffff0000u)};
                    o0 += a0 * wv[k][0]; o1 += a1 * wv[k][1]; }
                LAS float* dst = xcL + (tb + i) * XS + cb8; *(LAS f32x4*)dst = o0; *(LAS f32x4*)(dst + 4) = o1;
            }
        }
    }
    __syncthreads();
    const int g = wave;
    bf16x8 xa[4][2];
#pragma unroll
    for (int mt = 0; mt < 4; ++mt)
#pragma unroll
        for (int ks = 0; ks < 2; ++ks) {
            u32x4 w = {0u, 0u, 0u, 0u};
            if (!full && mt < nmt) { const LAS float* p = xcL + (16 * mt + fr) * XS + 64 * g + 32 * ks + 8 * fq; const f32x4 u = *(const LAS f32x4*)p, v = *(const LAS f32x4*)(p + 4);
                w.x = pk2(u[0], u[1]); w.y = pk2(u[2], u[3]); w.z = pk2(v[0], v[1]); w.w = pk2(v[2], v[3]); }
            xa[mt][ks] = __builtin_bit_cast(bf16x8, w);
        }
#pragma unroll
    for (int nt = 0; nt < 4; ++nt) {
        const int ch = 64 * g + 16 * nt + fr;
        const size_t sidx = ((size_t)b * NLC + c) * DLRU + ch;
        float h0 = 0.f, Lacc = 0.f;
        if (!full) {
            const bf16x8 wa0 = wfr[nt][0], wa1 = wfr[nt][1], wx0 = wfr[nt][2], wx1 = wfr[nt][3];
            const float ba = bav[nt], bx = bxv[nt], c2 = c2v[nt];
#pragma unroll
            for (int mt = 0; mt < 4; ++mt) {
                if (mt < nmt) {
                    f32x4 pa = {0.f, 0.f, 0.f, 0.f}, px = {0.f, 0.f, 0.f, 0.f};
                    pa = mfma16(xa[mt][0], wa0, pa); pa = mfma16(xa[mt][1], wa1, pa);
                    px = mfma16(xa[mt][0], wx0, px); px = mfma16(xa[mt][1], wx1, px);
                    float laf[4], ig[4];
#pragma unroll
                    for (int r = 0; r < 4; ++r) {
                        const float ea = 1.0f + __builtin_amdgcn_exp2f(fminf(pa[r] + ba, 57.f)), ex = 1.0f + __builtin_amdgcn_exp2f(fminf(px[r] + bx, 57.f)), inv = frcp(ea * ex);
                        laf[r] = c2 * (ex * inv); ig[r] = ea * inv;
                    }
                    u32x4 cv; cv.x = pg8::cvt_pk_bf16(laf[0], laf[1]); cv.y = pg8::cvt_pk_bf16(laf[2], laf[3]);
                    const float la[4] = {__uint_as_float(cv.x << 16), __uint_as_float(cv.x & 0xffff0000u), __uint_as_float(cv.y << 16), __uint_as_float(cv.y & 0xffff0000u)};
                    float av[4], bbf[4];
#pragma unroll
                    for (int r = 0; r < 4; ++r) { av[r] = __builtin_amdgcn_exp2f(la[r]); bbf[r] = __builtin_amdgcn_sqrtf(fmaxf(1.0f - av[r] * av[r], 0.f)) * ig[r] * xcL[(16 * mt + 4 * fq + r) * XS + ch]; }
                    cv.z = pg8::cvt_pk_bf16(bbf[0], bbf[1]); cv.w = pg8::cvt_pk_bf16(bbf[2], bbf[3]);
                    if (ldsc) { LAS unsigned* cw = (LAS unsigned*)xcL + (16 * mt + 4 * fq) * XS + ch;
                        cw[0] = (cv.x & 0xffffu) | (cv.z << 16); cw[XS] = (cv.x >> 16) | (cv.z & 0xffff0000u); cw[2 * XS] = (cv.y & 0xffffu) | (cv.w << 16); cw[3 * XS] = (cv.y >> 16) | (cv.w & 0xffff0000u); }
                    else *lc_item(b, c, g, nt, mt, lane) = cv;
                    const float bv[4] = {__uint_as_float(cv.z << 16), __uint_as_float(cv.z & 0xffff0000u), __uint_as_float(cv.w << 16), __uint_as_float(cv.w & 0xffff0000u)};
                    float A = 1.f, B = 0.f;
#pragma unroll
                    for (int r = 0; r < 4; ++r) { B = av[r] * B + bv[r]; A = A * av[r]; Lacc += la[r]; }
                    const float pA = __shfl_xor(A, 16), pB = __shfl_xor(B, 16);
                    const float PA = A * pA, PB = (fq & 1) ? A * pB + B : pA * B + pB;
                    const float qA = __shfl_xor(PA, 32), qB = __shfl_xor(PB, 32);
                    const float TA = PA * qA, TB = (fq & 2) ? PA * qB + PB : qA * PB + qB;
                    h0 = TA * h0 + TB;
                }
            }
        } else {
            h0 = ((const float*)(KA->ws + WS_CARRY))[sidx];
            u32x4 cv[4];
#pragma unroll
            for (int mt = 0; mt < 4; ++mt) if (mt < nmt) {
                if (ldsc) { const LAS unsigned* cw = (const LAS unsigned*)xcL + (16 * mt + 4 * fq) * XS + ch; const unsigned w0 = cw[0], w1 = cw[XS], w2 = cw[2 * XS], w3 = cw[3 * XS];
                    cv[mt].x = (w0 & 0xffffu) | (w1 << 16); cv[mt].y = (w2 & 0xffffu) | (w3 << 16); cv[mt].z = (w0 >> 16) | (w1 & 0xffff0000u); cv[mt].w = (w2 >> 16) | (w3 & 0xffff0000u); }
                else cv[mt] = *lc_item(b, c, g, nt, mt, lane);
            }
#pragma unroll
            for (int mt = 0; mt < 4; ++mt) {
                if (mt < nmt) {
                    const float la[4] = {__uint_as_float(cv[mt].x << 16), __uint_as_float(cv[mt].x & 0xffff0000u), __uint_as_float(cv[mt].y << 16), __uint_as_float(cv[mt].y & 0xffff0000u)};
                    const float bv[4] = {__uint_as_float(cv[mt].z << 16), __uint_as_float(cv[mt].z & 0xffff0000u), __uint_as_float(cv[mt].w << 16), __uint_as_float(cv[mt].w & 0xffff0000u)};
                    float Ar[4], Br[4]; float A = 1.f, B = 0.f;
#pragma unroll
                    for (int r = 0; r < 4; ++r) { const float av = __builtin_amdgcn_exp2f(la[r]); B = av * B + bv[r]; A = A * av; Ar[r] = A; Br[r] = B; }
                    const float pA = __shfl_xor(A, 16), pB = __shfl_xor(B, 16);
                    const float PA = A * pA, PB = (fq & 1) ? A * pB + B : pA * B + pB;
                    const float qA = __shfl_xor(PA, 32), qB = __shfl_xor(PB, 32);
                    float hin = h0;
                    if (fq & 2) hin = qA * hin + qB;
                    if (fq & 1) hin = pA * hin + pB;
                    const float TA = PA * qA, TB = (fq & 2) ? PA * qB + PB : qA * PB + qB;
                    h0 = TA * h0 + TB;
#pragma unroll
                    for (int r = 0; r < 4; ++r) xcL[(16 * mt + 4 * fq + r) * XS + ch] = Br[r] + Ar[r] * hin;
                }
            }
        }
        if (!full) {
            Lacc += __shfl_xor(Lacc, 16); Lacc += __shfl_xor(Lacc, 32);
            if (fq == 0) { ((float*)(KA->ws + WS_SUMH))[sidx] = h0; ((float*)(KA->ws + WS_SUML))[sidx] = Lacc; }
        }
    }
    if (full) {
        __syncthreads();
        const int tb = 8 * wave, cb8 = 8 * lane;
        if (tb < ntok) {
#pragma unroll
            for (int i = 0; i < 8; ++i) {
                const LAS float* hp = xcL + (tb + i) * XS + cb8; const f32x4 h0v = *(const LAS f32x4*)hp, h1v = *(const LAS f32x4*)(hp + 4);
                const u32x4 w = gr[i];
                float y[8];
                y[0] = h0v[0] * gelu_tanh(__uint_as_float(w.x << 16)); y[1] = h0v[1] * gelu_tanh(__uint_as_float(w.x & 0xffff0000u));
                y[2] = h0v[2] * gelu_tanh(__uint_as_float(w.y << 16)); y[3] = h0v[3] * gelu_tanh(__uint_as_float(w.y & 0xffff0000u));
                y[4] = h1v[0] * gelu_tanh(__uint_as_float(w.z << 16)); y[5] = h1v[1] * gelu_tanh(__uint_as_float(w.z & 0xffff0000u));
                y[6] = h1v[2] * gelu_tanh(__uint_as_float(w.w << 16)); y[7] = h1v[3] * gelu_tanh(__uint_as_float(w.w & 0xffff0000u));
                float ss = ((y[0] * y[0] + y[1] * y[1]) + (y[2] * y[2] + y[3] * y[3])) + ((y[4] * y[4] + y[5] * y[5]) + (y[6] * y[6] + y[7] * y[7]));
                ss = wave_sum(ss);
                const float rs = __builtin_amdgcn_rsqf(ss * (1.0f / DLRU) + EPS);
                u32x4 o; o.x = pk2(y[0] * rs * og0[0], y[1] * rs * og0[1]); o.y = pk2(y[2] * rs * og0[2], y[3] * rs * og0[3]); o.z = pk2(y[4] * rs * og1[0], y[5] * rs * og1[1]); o.w = pk2(y[6] * rs * og1[2], y[7] * rs * og1[3]);
                if (!nostore) *(u32x4*)(P + (size_t)(t0 + tb + i) * DIN + C_GL + cb8) = o;
            }
        }
    }
    __syncthreads();
}

__device__ __forceinline__ float lg2gamma(int h) { return log2f(1.0f - exp2f(-5.0f - (float)h)); }

constexpr int RS = 144;
typedef short s16x4 __attribute__((ext_vector_type(4)));
template <bool SCALE>
__device__ __forceinline__ void stage_R(LAS bf16_t* img, const bf16_t* P, int t0, int ntok, int col0, float lg, int cpos0, int tid) {
#pragma unroll
    for (int i = 0; i < 4; ++i) {
        const int idx = tid + NTHREADS * i, t = idx >> 4, cc = idx & 15;
        u32x4 w = {0u, 0u, 0u, 0u};
        if (t < ntok) w = *(const u32x4*)(P + (size_t)(t0 + t) * DIN + col0 + 8 * cc);
        if (SCALE) { const float sc = exp2f((float)(127 - (cpos0 + t)) * lg);
#pragma unroll
            for (int q = 0; q < 4; ++q) w[q] = pk2(__uint_as_float(w[q] << 16) * sc, __uint_as_float(w[q] & 0xffff0000u) * sc); }
        *(LAS u32x4*)(img + t * RS + 8 * cc) = w;
    }
}
__device__ __forceinline__ bf16x8 ld_tr(const LAS bf16_t* img, int r0, int r1, int d0, int fr) {
    const int q = fr >> 2, c4 = 4 * (fr & 3);
    const s16x4 x = __builtin_amdgcn_ds_read_tr16_b64_v4i16((LAS s16x4*)(img + (r0 + q) * RS + d0 + c4));
    const s16x4 y = __builtin_amdgcn_ds_read_tr16_b64_v4i16((LAS s16x4*)(img + (r1 + q) * RS + d0 + c4));
    return (bf16x8){x[0], x[1], x[2], x[3], y[0], y[1], y[2], y[3]};
}

struct KvRegs { u32x4 v[4], k[4]; };
__device__ __forceinline__ void kv_issue(KvRegs& R, int b, int n, int h, int tid) {
    const int t0 = n == 0 ? 0 : NMETA + 128 * (n - 1), ntok = n == 0 ? NMETA : 128;
    const bf16_t* P = (const bf16_t*)(KA->ws + WS_PROJ) + (size_t)b * TT * DIN;
#pragma unroll
    for (int i = 0; i < 4; ++i) { const int idx = tid + NTHREADS * i, t = idx >> 4, cc = idx & 15;
        R.v[i] = (u32x4){0u, 0u, 0u, 0u}; R.k[i] = (u32x4){0u, 0u, 0u, 0u};
        if (t < ntok) { const bf16_t* rp = P + (size_t)(t0 + t) * DIN + 128 * h + 8 * cc; R.v[i] = *(const u32x4*)(rp + C_V); R.k[i] = *(const u32x4*)(rp + C_K); } }
}
__device__ __forceinline__ void ret_kv_unit(LAS unsigned char* lds, int b, int n, int h, KvRegs& R, bool has_next, int nb, int nn, int nh) {
    const int tid = tidx(), lane = tid & 63, wave = __builtin_amdgcn_readfirstlane(tid >> 6), fr = lane & 15, fq = lane >> 4;
    const int ntok = n == 0 ? NMETA : 128, cpos0 = n == 0 ? 112 : 0;
    const float lg = lg2gamma(h);
    LAS bf16_t* vI = (LAS bf16_t*)lds; LAS bf16_t* kI = vI + 128 * RS;
#pragma unroll
    for (int i = 0; i < 4; ++i) { const int idx = tid + NTHREADS * i, t = idx >> 4, cc = idx & 15;
        *(LAS u32x4*)(vI + t * RS + 8 * cc) = R.v[i];
        const float sc = exp2f((float)(127 - (cpos0 + t)) * lg); u32x4 w = R.k[i];
#pragma unroll
        for (int q = 0; q < 4; ++q) w[q] = pk2(__uint_as_float(w[q] << 16) * sc, __uint_as_float(w[q] & 0xffff0000u) * sc);
        *(LAS u32x4*)(kI + t * RS + 8 * cc) = w; }
    __syncthreads();
    if (has_next) kv_issue(R, nb, nn, nh, tid);
    f32x4 acc[8];
#pragma unroll
    for (int dt = 0; dt < 8; ++dt) acc[dt] = (f32x4){0.f, 0.f, 0.f, 0.f};
    const int nkt = (ntok + 31) >> 5;
    for (int kt = 0; kt < nkt; ++kt) {
        const int r0 = 32 * kt + 8 * fq;
        const bf16x8 vf = ld_tr(vI, r0, r0 + 4, 16 * wave, fr);
#pragma unroll
        for (int dt = 0; dt < 8; ++dt) acc[dt] = mfma16(ld_tr(kI, r0, r0 + 4, 16 * dt, fr), vf, acc[dt]);
    }
    bf16_t* S = (bf16_t*)KA->out + ((size_t)((b * NH + h) * 16 + n)) * 16384 + (size_t)(16 * wave + fr) * 128 + 4 * fq;
#pragma unroll
    for (int dt = 0; dt < 8; ++dt) { u32x2 w; w.x = pk2(acc[dt][0], acc[dt][1]); w.y = pk2(acc[dt][2], acc[dt][3]); *(u32x2*)(S + 16 * dt) = w; }
    __syncthreads();
}

struct RetRegs { u32x4 v[4], k[4], s[4]; };
__device__ __forceinline__ void ret_issue(RetRegs& R, int b, int n, int h, int tid) {
    const int t0 = n == 0 ? 0 : NMETA + 128 * (n - 1), ntok = n == 0 ? NMETA : 128;
    const bf16_t* P = (const bf16_t*)(KA->ws + WS_PROJ) + (size_t)b * TT * DIN;
    const bf16_t* S = (const bf16_t*)KA->out + ((size_t)((b * NH + h) * 16 + (n >= 1 ? n - 1 : 0))) * 16384;
#pragma unroll
    for (int i = 0; i < 4; ++i) { const int idx = tid + NTHREADS * i, t = idx >> 4, cc = idx & 15;
        R.v[i] = (u32x4){0u, 0u, 0u, 0u}; R.k[i] = (u32x4){0u, 0u, 0u, 0u}; R.s[i] = (u32x4){0u, 0u, 0u, 0u};
        if (t < ntok) { const bf16_t* rp = P + (size_t)(t0 + t) * DIN + 128 * h + 8 * cc; R.v[i] = *(const u32x4*)(rp + C_V); R.k[i] = *(const u32x4*)(rp + C_K); }
        if (n >= 1) R.s[i] = *(const u32x4*)(S + t * 128 + 8 * cc); }
}
__device__ __forceinline__ void ret_out_unit(LAS unsigned char* lds, int l, int b, int n, int h, RetRegs& R, bool has_next, int nb, int nn, int nh) {
    const bool nostore = false;
    const int tid = tidx(), lane = tid & 63, wave = __builtin_amdgcn_readfirstlane(tid >> 6), fr = lane & 15, fq = lane >> 4;
    const int t0 = n == 0 ? 0 : NMETA + 128 * (n - 1), ntok = n == 0 ? NMETA : 128;
    const float lg = lg2gamma(h);
    LAS bf16_t* vI = (LAS bf16_t*)lds; LAS bf16_t* SL = vI + 128 * RS; LAS bf16_t* kL = SL + 128 * SS;
    bf16_t* P = (bf16_t*)(KA->ws + WS_PROJ) + (size_t)b * TT * DIN;
#pragma unroll
    for (int i = 0; i < 4; ++i) { const int idx = tid + NTHREADS * i, t = idx >> 4, cc = idx & 15;
        *(LAS u32x4*)(vI + t * RS + 8 * cc) = R.v[i]; *(LAS u32x4*)(kL + t * SS + 8 * cc) = R.k[i];
        if (n >= 1) *(LAS u32x4*)(SL + t * SS + 8 * cc) = R.s[i]; }
    __syncthreads();
    if (has_next) ret_issue(R, nb, nn, nh, tid);
    if (16 * wave < ntok) {
        const int c = 16 * wave + fr;
        bf16_t* qrow = P + (size_t)(t0 + c) * DIN + 128 * h;
        bf16x8 qf[4];
#pragma unroll
        for (int kd = 0; kd < 4; ++kd) qf[kd] = *(const bf16x8*)(qrow + C_Q + 32 * kd + 8 * fq);
        f32x4 y[8];
#pragma unroll
        for (int et = 0; et < 8; ++et) y[et] = (f32x4){0.f, 0.f, 0.f, 0.f};
        if (n >= 1) {
            const float xi = exp2f((float)(c + 1) * lg);
#pragma unroll
            for (int et = 0; et < 8; ++et) {
#pragma unroll
                for (int kd = 0; kd < 4; ++kd) y[et] = mfma16(*(const LAS bf16x8*)(SL + (16 * et + fr) * SS + 32 * kd + 8 * fq), qf[kd], y[et]);
                y[et] = y[et] * xi;
            }
        }
        for (int p = 0; p <= (wave >> 1); ++p) {
            f32x4 sc0 = {0.f, 0.f, 0.f, 0.f}, sc1 = {0.f, 0.f, 0.f, 0.f};
            { const LAS bf16_t* kr = kL + (32 * p + fr) * SS + 8 * fq;
#pragma unroll
              for (int kd = 0; kd < 4; ++kd) sc0 = mfma16(*(const LAS bf16x8*)(kr + 32 * kd), qf[kd], sc0); }
            if (2 * p + 1 <= wave) { const LAS bf16_t* kr = kL + (32 * p + 16 + fr) * SS + 8 * fq;
#pragma unroll
              for (int kd = 0; kd < 4; ++kd) sc1 = mfma16(*(const LAS bf16x8*)(kr + 32 * kd), qf[kd], sc1); }
            float pv[8];
#pragma unroll
            for (int j = 0; j < 4; ++j) { const int s0 = 32 * p + 4 * fq + j, s1 = s0 + 16;
                pv[j] = (c >= s0) ? sc0[j] * __builtin_amdgcn_exp2f((float)(c - s0) * lg) : 0.f; pv[4 + j] = (c >= s1) ? sc1[j] * __builtin_amdgcn_exp2f((float)(c - s1) * lg) : 0.f; }
            u32x4 w; w.x = pk2(pv[0], pv[1]); w.y = pk2(pv[2], pv[3]); w.z = pk2(pv[4], pv[5]); w.w = pk2(pv[6], pv[7]);
            const bf16x8 pf = __builtin_bit_cast(bf16x8, w);
#pragma unroll
            for (int et = 0; et < 8; ++et) y[et] = mfma16(ld_tr(vI, 32 * p + 4 * fq, 32 * p + 16 + 4 * fq, 16 * et, fr), pf, y[et]);
        }
        float s1 = 0.f;
#pragma unroll
        for (int et = 0; et < 8; ++et) s1 += (y[et][0] + y[et][1]) + (y[et][2] + y[et][3]);
        s1 += __shfl_xor(s1, 16); s1 += __shfl_xor(s1, 32);
        const float mu = s1 * (1.0f / 128.0f);
        float s2 = 0.f;
#pragma unroll
        for (int et = 0; et < 8; ++et) { y[et] = y[et] - mu; s2 += (y[et][0] * y[et][0] + y[et][1] * y[et][1]) + (y[et][2] * y[et][2] + y[et][3] * y[et][3]); }
        s2 += __shfl_xor(s2, 16); s2 += __shfl_xor(s2, 32);
        const float rs = rsqrtf(s2 * (1.0f / 128.0f) + EPS);
        const float* gn = KA->in[I_RETN] + l * 512 + 128 * h + 4 * fq;
#pragma unroll
        for (int et = 0; et < 8; ++et) {
            const u32x2 gw = *(const u32x2*)(qrow + C_GR + 16 * et + 4 * fq); const f32x4 gv = *(const f32x4*)(gn + 16 * et);
            const float g0 = __uint_as_float(gw.x << 16), g1 = __uint_as_float(gw.x & 0xffff0000u), g2 = __uint_as_float(gw.y << 16), g3 = __uint_as_float(gw.y & 0xffff0000u);
            u32x2 o; o.x = pk2(y[et][0] * rs * gv[0] * g0 * sigmoidf_(g0), y[et][1] * rs * gv[1] * g1 * sigmoidf_(g1)); o.y = pk2(y[et][2] * rs * gv[2] * g2 * sigmoidf_(g2), y[et][3] * rs * gv[3] * g3 * sigmoidf_(g3));
            if (!nostore) *(u32x2*)(qrow + C_V + 16 * et + 4 * fq) = o;
        }
    }
    __syncthreads();
}

__device__ __forceinline__ void prefix_phase(int G, bool nostore = false) {
    const int gt = bidx() * NTHREADS + tidx(), NGT = G * NTHREADS;
    bf16_t* SB = (bf16_t*)KA->out;
    for (int i = gt; i < NB * NH * 4096; i += NGT) {
        const int bh = i >> 12, ed = (i & 4095) * 4, h = bh & 3;
        const float g128 = exp2f(128.0f * lg2gamma(h));
        u32x2* base = (u32x2*)(SB + (size_t)bh * 16 * 16384 + ed);
        u32x2 v[16];
#pragma unroll
        for (int n = 0; n < 16; ++n) v[n] = base[(size_t)n * 4096];
        f32x4 run = {__uint_as_float(v[0].x << 16), __uint_as_float(v[0].x & 0xffff0000u), __uint_as_float(v[0].y << 16), __uint_as_float(v[0].y & 0xffff0000u)};
#pragma unroll
        for (int n = 1; n < 16; ++n) {
            const f32x4 kv = {__uint_as_float(v[n].x << 16), __uint_as_float(v[n].x & 0xffff0000u), __uint_as_float(v[n].y << 16), __uint_as_float(v[n].y & 0xffff0000u)};
            run = run * g128 + kv;
            u32x2 w; w.x = pk2(run[0], run[1]); w.y = pk2(run[2], run[3]);
            if (!nostore) base[(size_t)n * 4096] = w;
        }
    }
    const float* sh = (const float*)(KA->ws + WS_SUMH); const float* sl = (const float*)(KA->ws + WS_SUML); float* cr = (float*)(KA->ws + WS_CARRY);
    for (int i = gt; i < NB * DLRU; i += NGT) {
        const int b = i >> 9, ch = i & 511; const size_t i0 = (size_t)b * NLC * DLRU + ch;
        float hh[NLC], ll[NLC];
#pragma unroll
        for (int c = 0; c < NLC; ++c) { hh[c] = sh[i0 + (size_t)c * DLRU]; ll[c] = sl[i0 + (size_t)c * DLRU]; }
        float h = 0.f;
#pragma unroll
        for (int c = 0; c < NLC; ++c) { if (!nostore) cr[i0 + (size_t)c * DLRU] = h; h = hh[c] + __builtin_amdgcn_exp2f(ll[c]) * h; }
    }
}

constexpr int N_PHASES = 2 + 7 * DEPTH;

__global__ void __launch_bounds__(NTHREADS, 2) hymba_fwd(Args a) {
    extern __shared__ __attribute__((aligned(16))) unsigned char lds_raw[];
    LAS unsigned char* lds = (LAS unsigned char*)lds_raw;
    const int G = gridDim.x;
#if MK_PER_PHASE
    const int lo = KA->ph_lo, hi = KA->ph_hi;
#define IN(k) (lo <= (k) && (k) < hi)
#define SEAM(k) do { } while (0)
#else
#define IN(k) true
#define SEAM(k) do { XcdBarrier b_; b_.bar = (unsigned*)(KA->ws); b_.x = xb_xcc_id(); b_.st = (volatile LAS unsigned*)(lds + LDS_BYTES - 64); xcd_barrier(b_); } while (0)
#endif
#define P_HB ((bf16_t*)(KA->ws + WS_HB))
#define P_PROJ ((bf16_t*)(KA->ws + WS_PROJ))
#define P_SSQ ((float*)(KA->ws + WS_SSQ))
#define P_HM ((float*)(KA->ws + WS_HM))
#define P_ROPE ((const f32x2*)(KA->ws + WS_ROPE))
#define P_W(l) ((const bf16_t*)(KA->ws + WS_W) + (size_t)(l) * W_LAYER_E)
    int ph = 0;
#if !MK_PER_PHASE
    if (threadIdx.x < 16) ((LAS unsigned*)(lds + LDS_BYTES - 64))[threadIdx.x] = 0u;
    __syncthreads();
    (void)xcd_barrier_post((unsigned*)(KA->ws), (volatile LAS unsigned*)(lds + LDS_BYTES - 64));
#endif

    if (IN(ph)) prologue(lds, G);
#ifdef PROBE_DUP_PRO
    prologue(lds, G);
#endif
#if !MK_PER_PHASE
    SEAM(ph);
    if (KA->ph_hi == 0x7fffffff) cg::this_grid().sync();
#endif
    ++ph;

    for (int l = 0; l < DEPTH; ++l) {
        if (IN(ph)) {
            { pg8::Gemm g{P_HB, P_W(l), DM, DIN, DM}; pg8::StaticOrder S; S.init(MROWS, DIN, G, bidx(), 2);
              pg8::fill_rstd_tables(lds, P_SSQ, S);
              pg8::EpiProj E{P_PROJ, (const LAS float*)(lds + pg8::RSTD_OFF), P_ROPE};
              pg8::gemm_phase<pg8::EpiProj, true, true>(lds, g, S, E);
#ifdef PROBE_DUP_G1
              pg8::gemm_phase<pg8::EpiProj, true, true>(lds, g, S, E);
#endif
            }
            if (bidx() < DIN / 16) skinny_item<0, DM>(lds, bidx(), P_HM, nullptr, 0, P_W(l), nullptr, P_PROJ, P_ROPE);
        }
        SEAM(ph); ++ph;
        if (IN(ph)) {
            constexpr int NL = NB * NLC, NR = NB * 16 * NH;
            const bool ldsc = G >= 256;
            int u = bidx() + 256;
            for (; u < NL; u += G) lru_unit(lds, l, u - 256, 0, false);
            if (u < NL + NR) {
                KvRegs R; int r = u - NL, kb, kn, kh;
                if (r < 480) { kb = r / 60; kn = 1 + ((r % 60) >> 2); kh = r & 3; } else { kb = (r - 480) >> 2; kn = 0; kh = r & 3; }
                kv_issue(R, kb, kn, kh, tidx());
                for (;;) {
                    const int rn = r + G; const bool hn = rn < NR; int nb2 = 0, nn2 = 0, nh2 = 0;
                    if (hn) { if (rn < 480) { nb2 = rn / 60; nn2 = 1 + ((rn % 60) >> 2); nh2 = rn & 3; } else { nb2 = (rn - 480) >> 2; nn2 = 0; nh2 = rn & 3; } }
                    ret_kv_unit(lds, kb, kn, kh, R, hn, nb2, nn2, nh2);
                    if (!hn) break;
                    r = rn; kb = nb2; kn = nn2; kh = nh2;
                }
            }
            for (int u = bidx(); u < 256; u += G) lru_unit(lds, l, u >> 5, 1 + (u & 31), false, false, ldsc);
        }
#ifdef PROBE_DUP_SYNC
        SEAM(ph); SEAM(ph); SEAM(ph); SEAM(ph); SEAM(ph); SEAM(ph); SEAM(ph);
#endif
        SEAM(ph); ++ph;
#ifdef PROBE_DRY_M15
        prefix_phase(G, KA->ph_lo == 0);
#endif
        if (IN(ph)) prefix_phase(G);
        SEAM(ph); ++ph;
        if (IN(ph)) {
            constexpr int NL = NB * NLC, NR = NB * NRC * NH;
            const bool ldsc = G >= 256;
            for (int u = bidx(); u < 256; u += G) lru_unit(lds, l, u >> 5, 1 + (u & 31), true, false, ldsc);
            int u = bidx() + 256;
            for (; u < NL; u += G) lru_unit(lds, l, u - 256, 0, true);
            if (u < NL + NR) {
                RetRegs R; int r = u - NL, rb, rn_, rh;
                if (r < 512) { rb = r >> 6; rn_ = 1 + ((r >> 2) & 15); rh = r & 3; } else { rb = (r - 512) >> 2; rn_ = 0; rh = r & 3; }
                ret_issue(R, rb, rn_, rh, tidx());
                for (;;) {
                    const int r2 = r + G; const bool hn = r2 < NR; int nb2 = 0, nn2 = 0, nh2 = 0;
                    if (hn) { if (r2 < 512) { nb2 = r2 >> 6; nn2 = 1 + ((r2 >> 2) & 15); nh2 = r2 & 3; } else { nb2 = (r2 - 512) >> 2; nn2 = 0; nh2 = r2 & 3; } }
                    ret_out_unit(lds, l, rb, rn_, rh, R, hn, nb2, nn2, nh2);
                    if (!hn) break;
                    r = r2; rb = nb2; rn_ = nn2; rh = nh2;
                }
            }
        }
        SEAM(ph); ++ph;
        if (IN(ph)) {
            { pg8::Gemm g{P_PROJ + C_GL, P_W(l) + W_IN_E, DIN, DM, DM}; pg8::StaticOrder S; S.init(MROWS, DM, G, bidx());
#ifdef PROBE_DRY_G24
              { pg8::EpiDry Ed{P_SSQ}; pg8::gemm_phase<pg8::EpiDry, false, true>(lds, g, S, Ed); }
#endif

              pg8::EpiRes E{P_HB, P_SSQ};
              pg8::gemm_phase<pg8::EpiRes, false, true>(lds, g, S, E); }
            if (bidx() < DM / 16) skinny_item<1, DM>(lds, bidx(), nullptr, P_PROJ + C_GL, DIN, P_W(l) + W_IN_E, P_HM, nullptr, nullptr);
        }
        SEAM(ph); ++ph;
        if (IN(ph)) {
            { pg8::Gemm g{P_HB, P_W(l) + W_IN_E + W_OUT_E, DM, 2 * DFF, DM}; pg8::StaticOrder S; S.init(MROWS, 2 * DFF, G, bidx());
              pg8::fill_rstd_tables(lds, P_SSQ, S);
              pg8::EpiGlu E{P_PROJ, (const LAS float*)(lds + pg8::RSTD_OFF)};
              pg8::gemm_phase<pg8::EpiGlu, true, true>(lds, g, S, E);
#ifdef PROBE_DUP_G3
              pg8::gemm_phase<pg8::EpiGlu, true, true>(lds, g, S, E);
#endif
            }
            for (int i = bidx() - G / 2; i >= 0 && i < DFF / 16; i += G / 2) skinny_item<2, DM>(lds, i, P_HM, nullptr, 0, P_W(l) + W_IN_E + W_OUT_E, nullptr, P_PROJ, nullptr);
        }
        SEAM(ph); ++ph;
        if (IN(ph)) {
            { pg8::Gemm g{P_PROJ, P_W(l) + W_IN_E + W_OUT_E + W_GU_E, DFF, DM, DFF}; pg8::StaticOrder S; S.init(MROWS, DM, G, bidx());
#ifdef PROBE_DRY_G24
              { pg8::EpiDry Ed{P_SSQ}; pg8::gemm_phase<pg8::EpiDry, false, true>(lds, g, S, Ed); }
#endif

              pg8::EpiRes E{P_HB, P_SSQ};
              pg8::gemm_phase<pg8::EpiRes, false, true>(lds, g, S, E); }
            if (bidx() < DM / 16) skinny_item<1, DFF>(lds, bidx(), nullptr, P_PROJ, DFF, P_W(l) + W_IN_E + W_OUT_E + W_GU_E, P_HM, nullptr, nullptr);
        }
        SEAM(ph); ++ph;
    }
    if (IN(ph)) {
        const int tid = tidx(), lane = tid & 63, gw = bidx() * 8 + (tid >> 6), NGW = G * 8;
        const float* gnp = KA->in[I_NFIN] + 8 * lane; const f32x4 g0 = *(const f32x4*)gnp, g1 = *(const f32x4*)(gnp + 4), g2 = *(const f32x4*)(gnp + 512), g3 = *(const f32x4*)(gnp + 516);
        const float* ssq = P_SSQ; float* outp = KA->out; const bf16_t* hbp = P_HB;
        for (int m0 = gw; m0 < MROWS; m0 += 4 * NGW) {
            f32x4 sq[4][4]; u32x4 ha[4], hb2[4];
#pragma unroll
            for (int q = 0; q < 4; ++q) { const int m = m0 + q * NGW; if (m < MROWS) {
                const f32x4* sp = (const f32x4*)(ssq + (size_t)m * 16); sq[q][0] = sp[0]; sq[q][1] = sp[1]; sq[q][2] = sp[2]; sq[q][3] = sp[3];
                const u32x4* hr = (const u32x4*)(hbp + (size_t)rowX(m) * DM) + lane; ha[q] = hr[0]; hb2[q] = hr[64]; } }
#pragma unroll
            for (int q = 0; q < 4; ++q) { const int m = m0 + q * NGW; if (m < MROWS) {
                const f32x4 t = (sq[q][0] + sq[q][1]) + (sq[q][2] + sq[q][3]);
                const float rs = rsqrtf(((t[0] + t[1]) + (t[2] + t[3])) * (1.0f / DM) + EPS);
                const u32x4 a = ha[q], b = hb2[q];
                f32x4* xr = (f32x4*)(outp + (size_t)m * DM) + 2 * lane;
                xr[0] = (f32x4){__uint_as_float(a.x << 16), __uint_as_float(a.x & 0xffff0000u), __uint_as_float(a.y << 16), __uint_as_float(a.y & 0xffff0000u)} * rs * g0;
                xr[1] = (f32x4){__uint_as_float(a.z << 16), __uint_as_float(a.z & 0xffff0000u), __uint_as_float(a.w << 16), __uint_as_float(a.w & 0xffff0000u)} * rs * g1;
                xr[128] = (f32x4){__uint_as_float(b.x << 16), __uint_as_float(b.x & 0xffff0000u), __uint_as_float(b.y << 16), __uint_as_float(b.y & 0xffff0000u)} * rs * g2;
                xr[129] = (f32x4){__uint_as_float(b.z << 16), __uint_as_float(b.z & 0xffff0000u), __uint_as_float(b.w << 16), __uint_as_float(b.w & 0xffff0000u)} * rs * g3; } }
        }
    }
#undef IN
#undef SEAM
}

#ifndef MK_PER_PHASE
#define MK_PER_PHASE 0
#endif
extern "C" void kernel_launch(void* const* d_in, const int* in_sizes, int n_in, void* d_out, int out_size, void* d_ws, size_t ws_size, hipStream_t stream) {
    static int grid = 0;
    if (grid == 0) {
        if (n_in != 19 || out_size != MROWS * DM || ws_size < WS_END) { fprintf(stderr, "kernel_launch: unexpected shapes (n_in %d out %d ws %zu)\n", n_in, out_size, ws_size); grid = -1; return; }
        int dev = 0, cus = 0, per_cu = 0;
        hipGetDevice(&dev); hipDeviceGetAttribute(&cus, hipDeviceAttributeMultiprocessorCount, dev);
        if (hipFuncSetAttribute((const void*)hymba_fwd, hipFuncAttributeMaxDynamicSharedMemorySize, LDS_BYTES) != hipSuccess) { fprintf(stderr, "kernel_launch: hipFuncSetAttribute failed\n"); grid = -1; return; }
        if (hipOccupancyMaxActiveBlocksPerMultiprocessor(&per_cu, (const void*)hymba_fwd, NTHREADS, LDS_BYTES) != hipSuccess || per_cu < 1) { fprintf(stderr, "kernel_launch: occupancy query says %d\n", per_cu); per_cu = 1; }
        (void)hipGetLastError();
        grid = cus * 1;
        if (grid <= 0) grid = 256;
    }
    if (grid < 0) return;
    if (hipMemsetAsync(d_ws, 0, 16384, stream) != hipSuccess) { fprintf(stderr, "kernel_launch: memset failed\n"); return; }
    Args a{};
    for (int i = 0; i < 19; ++i) a.in[i] = (const float*)d_in[i];
    a.out = (float*)d_out; a.ws = (unsigned char*)d_ws;
#if MK_PER_PHASE
    for (int p = 0; p < N_PHASES; ++p) { a.ph_lo = p; a.ph_hi = p + 1; hipLaunchKernelGGL(hymba_fwd, dim3(grid), dim3(NTHREADS), LDS_BYTES, stream, a); }
#else
    a.ph_lo = 0; a.ph_hi = N_PHASES;
    void* args[] = {&a};
    hipError_t e = hipLaunchCooperativeKernel((const void*)hymba_fwd, dim3(grid), dim3(NTHREADS), args, LDS_BYTES, stream);
    if (e != hipSuccess) fprintf(stderr, "cooperative launch failed: %s (grid %d)\n", hipGetErrorString(e), grid);
#endif
}
```

```cpp
#include <hip/hip_runtime.h>
#include <hip/hip_cooperative_groups.h>
#include <cstdio>
#include <cstdint>
namespace cg = cooperative_groups;

#define LAS __attribute__((address_space(3)))
typedef unsigned short bf16_t;
typedef short bf16x8 __attribute__((ext_vector_type(8)));
typedef float f32x4 __attribute__((ext_vector_type(4)));
typedef float f32x2 __attribute__((ext_vector_type(2)));
typedef unsigned u32x4 __attribute__((ext_vector_type(4)));
typedef unsigned u32x2 __attribute__((ext_vector_type(2)));

constexpr int NB = 8, SEQ = 2048, NMETA = 16, TT = SEQ + NMETA, DM = 1024, DIN = 3072, DFF = 2816, DEPTH = 4;
constexpr int MROWS = NB * SEQ;
constexpr int XROWS = NB * TT;
constexpr int DLRU = 512, HD = 128, NH = 4;
constexpr float EPS = 1e-6f;
constexpr int C_XL = 0, C_Q = 512, C_K = 1024, C_GL = 1536, C_V = 2048, C_GR = 2560;
constexpr int NLC = 33;
constexpr int NRC = 17;

__host__ __device__ __forceinline__ int rowX_tile(int pm) { return pm * 256 + 16 * (pm >> 3) + 16; }
__device__ __forceinline__ int rowX(int m) { return m + 16 * (m >> 11) + 16; }

constexpr size_t MiB = 1u << 20;
constexpr size_t WS_ROPE = 1 * MiB;
constexpr size_t WS_SSQ = 3 * MiB;
constexpr size_t WS_HM = 4 * MiB;
constexpr size_t WS_SUMH = 5 * MiB, WS_SUML = 6 * MiB, WS_CARRY = 7 * MiB;
constexpr size_t WS_WAX = 8 * MiB;
constexpr size_t WS_W = 10 * MiB;
constexpr size_t W_IN_E = (size_t)DIN * DM, W_OUT_E = (size_t)DM * DM, W_GU_E = (size_t)2 * DFF * DM, W_D_E = (size_t)DM * DFF;
constexpr size_t W_LAYER_E = W_IN_E + W_OUT_E + W_GU_E + W_D_E;
constexpr size_t WS_HB = 108 * MiB;
constexpr size_t WS_PROJ = 141 * MiB;
constexpr size_t WS_END = 238 * MiB;
constexpr size_t LC_BATCH = (size_t)NLC * 8 * 4 * 4 * 64 * 16;
constexpr size_t WS_LC1 = WS_HB + 16 * MiB;
constexpr size_t WS_LC2 = WS_END;
constexpr size_t WS_END2 = WS_LC2 + 5 * LC_BATCH;
static_assert(16 * MiB + 8 * LC_BATCH <= (size_t)MROWS * DM * 4, "retention state + LRU cache fit in d_out");
static_assert(WS_W + W_LAYER_E * 2 * DEPTH <= WS_HB && WS_HB + (size_t)XROWS * DM * 2 <= WS_PROJ && WS_PROJ + (size_t)XROWS * DIN * 2 <= WS_END, "ws map");

constexpr int LDS_BYTES = 147456;
constexpr int NTHREADS = 512;

__device__ __forceinline__ int tidx() { int t = threadIdx.x; asm volatile("" : "+v"(t)); return t; }
__device__ __forceinline__ int bidx() { int b = __builtin_amdgcn_readfirstlane((int)blockIdx.x); asm volatile("" : "+s"(b)); return b; }
__device__ __forceinline__ float bf2f(bf16_t u) { return __uint_as_float((unsigned)u << 16); }
__device__ __forceinline__ unsigned f2bf(float f) { unsigned u = __float_as_uint(f); return (u + 0x7fffu + ((u >> 16) & 1u)) >> 16; }
__device__ __forceinline__ unsigned pk2(float lo, float hi) { return f2bf(lo) | (f2bf(hi) << 16); }
__device__ __forceinline__ float wave_sum(float v) {
#pragma unroll
    for (int o = 1; o < 64; o <<= 1) v += __shfl_xor(v, o);
    return v;
}
__device__ __forceinline__ float frcp(float x) { return __builtin_amdgcn_rcpf(x); }
__device__ __forceinline__ float fexp(float x) { return __builtin_amdgcn_exp2f(x * 1.4426950408889634f); }
__device__ __forceinline__ float sigmoidf_(float x) { return frcp(1.0f + fexp(-x)); }
__device__ __forceinline__ float gelu_tanh(float x) { const float z = 0.7978845608028654f * (x + 0.044715f * x * x * x); const float t = 1.0f - 2.0f * frcp(1.0f + fexp(2.0f * z)); return 0.5f * x * (1.0f + t); }

__device__ const double INVF[64] = {1.0, 0.8659643233600653, 0.7498942093324559, 0.6493816315762113, 0.5623413251903491, 0.4869675251658631, 0.4216965034285822, 0.3651741272548377, 0.31622776601683794, 0.27384196342643613, 0.23713737056616552, 0.2053525026457146, 0.1778279410038923, 0.1539926526059492, 0.1333521432163324, 0.11547819846894582, 0.1, 0.08659643233600653, 0.07498942093324558, 0.06493816315762113, 0.05623413251903491, 0.04869675251658631, 0.042169650342858224, 0.03651741272548377, 0.03162277660168379, 0.027384196342643614, 0.023713737056616554, 0.02053525026457146, 0.01778279410038923, 0.01539926526059492, 0.01333521432163324, 0.011547819846894581, 0.01, 0.008659643233600654, 0.007498942093324558, 0.006493816315762113, 0.005623413251903491, 0.004869675251658631, 0.004216965034285823, 0.003651741272548377, 0.0031622776601683794, 0.0027384196342643613, 0.0023713737056616554, 0.002053525026457146, 0.0017782794100389228, 0.001539926526059492, 0.001333521432163324, 0.0011547819846894581, 0.001, 0.0008659643233600654, 0.0007498942093324559, 0.0006493816315762113, 0.0005623413251903491, 0.0004869675251658631, 0.00042169650342858224, 0.0003651741272548377, 0.00031622776601683794, 0.0002738419634264361, 0.00023713737056616554, 0.0002053525026457146, 0.00017782794100389227, 0.0001539926526059492, 0.0001333521432163324, 0.00011547819846894582};

namespace pg8 {
constexpr int BM = 256, BK = 64, HALF = 128, HTB = HALF * BK * 2, STAGE_BYTES = 8 * HTB, NXCD = 8, WGM = 4;
__device__ __forceinline__ int lds_byte(int r, int c) { const int st = (r >> 4) * 2 + (c >> 5), rr = r & 15, cc = c & 31, ob = rr * 64 + cc * 2; return st * 1024 + (ob ^ (((ob >> 9) & 1) << 5)); }
__device__ __forceinline__ void stage_rc(int b, int& R, int& C) { const int st = b / 1024, sb = b % 1024, swz = sb ^ (((sb >> 9) & 1) << 5); R = (st >> 1) * 16 + swz / 64; C = (st & 1) * 32 + (swz % 64) / 2; }
__device__ __forceinline__ int perm32(int rho) { const int n = rho >> 4, i = rho & 15; return 8 * (i >> 2) + 4 * n + (i & 3); }

struct Unit { int pm, pn, idx; };
struct Gemm { const bf16_t* A; const bf16_t* Bt; int lda, N, K; };

struct StaticOrder {
    int nM, nN, nwg, G, c, wgm;
    __device__ void init(int M, int N, int G_, int c_, int wgm_ = WGM) { nM = M / BM; nN = N / BM; nwg = nM * nN; G = G_; c = c_; wgm = wgm_; }
    __device__ bool next(int i, Unit& u) const {
        const long L = (long)i * G + c; if (L >= nwg) return false;
        int wgid = (int)L; { const int q = nwg / NXCD, r = nwg % NXCD, xcd = wgid % NXCD, off = wgid / NXCD; wgid = (xcd < r ? xcd * (q + 1) : r * (q + 1) + (xcd - r) * q) + off; }
        const int nig = wgm * nN, gid = wgid / nig, fm = gid * wgm, gsz = (nM - fm) < wgm ? (nM - fm) : wgm;
        u.pm = fm + ((wgid % nig) % gsz); u.pn = (wgid % nig) / gsz; return true;
    }
};

__device__ __forceinline__ unsigned cvt_pk_bf16(float lo, float hi) { unsigned r; asm volatile("v_cvt_pk_bf16_f32 %0, %1, %2" : "=v"(r) : "v"(lo), "v"(hi)); return r; }

__device__ __forceinline__ float row_rstd(const float* ssq, int rowm) {
    const f32x4* sp = (const f32x4*)(ssq + (size_t)rowm * 16);
    const f32x4 a = sp[0], b = sp[1], c = sp[2], d = sp[3];
    const float s = ((a[0] + a[1]) + (a[2] + a[3])) + ((b[0] + b[1]) + (b[2] + b[3])) + ((c[0] + c[1]) + (c[2] + c[3])) + ((d[0] + d[1]) + (d[2] + d[3]));
    return rsqrtf(s * (1.0f / DM) + EPS);
}

constexpr int RSTD_OFF = 131072, RSTD_MAX_UNITS = 8;
__device__ __forceinline__ void fill_rstd_tables(LAS unsigned char* lds, const float* ssq, const StaticOrder& S) {
    const int tid = tidx(), row = tid & 255; const bool odd = tid >= 256;
    LAS float* tab = (LAS float*)(lds + RSTD_OFF);
    f32x4 v[RSTD_MAX_UNITS / 2][4]; bool have[RSTD_MAX_UNITS / 2];
#pragma unroll
    for (int k = 0; k < RSTD_MAX_UNITS / 2; ++k) {
        Unit ua, ub; const bool ha = S.next(2 * k, ua), hb = S.next(2 * k + 1, ub);
        have[k] = odd ? hb : ha; const int pm = odd ? ub.pm : ua.pm;
        if (have[k]) { const f32x4* sp = (const f32x4*)(ssq + (size_t)(pm * BM + row) * 16); v[k][0] = sp[0]; v[k][1] = sp[1]; v[k][2] = sp[2]; v[k][3] = sp[3]; }
    }
#pragma unroll
    for (int k = 0; k < RSTD_MAX_UNITS / 2; ++k)
        if (have[k]) { const f32x4 t = (v[k][0] + v[k][1]) + (v[k][2] + v[k][3]);
            tab[(2 * k + (odd ? 1 : 0)) * 256 + row] = rsqrtf(((t[0] + t[1]) + (t[2] + t[3])) * (1.0f / DM) + EPS); }
    __syncthreads();
}
struct EpiProj {
    static constexpr bool PERM = true;
    bf16_t* P; const LAS float* rtab; const f32x2* rope;
    __device__ __forceinline__ void operator()(const f32x4 (&acc)[2][2][4][2], const Unit& u, int wr, int wc, int fr, int fq) const {
        const bool dorope = (u.pn >= 2 && u.pn < 6);
        const __amdgpu_buffer_rsrc_t rsrc = __builtin_amdgcn_make_buffer_rsrc(P, 0, XROWS * DIN * 2, 0x00020000);
#pragma unroll
        for (int ai = 0; ai < 2; ++ai)
#pragma unroll
            for (int m = 0; m < 4; ++m) {
                const int rl = ai * HALF + wr * 64 + m * 16 + fr, rowm = u.pm * BM + rl;
                const float rs = rtab[u.idx * 256 + rl];
                bf16_t* rowp = P + (size_t)(rowX_tile(u.pm) + rl) * DIN + u.pn * BM + wc * 32 + 8 * fq;
                f32x4 cs0 = {1.f, 0.f, 1.f, 0.f}, cs1 = {1.f, 0.f, 1.f, 0.f};
                if (dorope) { const f32x4* rp = (const f32x4*)(rope + (size_t)(NMETA + (rowm & (SEQ - 1))) * 64 + 16 * wc + 4 * fq); cs0 = rp[0]; cs1 = rp[1]; }
#pragma unroll
                for (int bj = 0; bj < 2; ++bj) {
                    f32x4 v0 = acc[ai][bj][m][0] * rs, v1 = acc[ai][bj][m][1] * rs;
                    if (dorope) {
                        const f32x4 a = v0, b = v1;
                        v0[0] = a[0] * cs0[0] - a[1] * cs0[1]; v0[1] = a[0] * cs0[1] + a[1] * cs0[0];
                        v0[2] = a[2] * cs0[2] - a[3] * cs0[3]; v0[3] = a[2] * cs0[3] + a[3] * cs0[2];
                        v1[0] = b[0] * cs1[0] - b[1] * cs1[1]; v1[1] = b[0] * cs1[1] + b[1] * cs1[0];
                        v1[2] = b[2] * cs1[2] - b[3] * cs1[3]; v1[3] = b[2] * cs1[3] + b[3] * cs1[2];
                    }
                    u32x4 w; w.x = cvt_pk_bf16(v0[0], v0[1]); w.y = cvt_pk_bf16(v0[2], v0[3]); w.z = cvt_pk_bf16(v1[0], v1[1]); w.w = cvt_pk_bf16(v1[2], v1[3]);
                    __builtin_amdgcn_raw_buffer_store_b128(w, rsrc, (int)((rowp + bj * HALF - P) * 2), 0, 16);
                }
            }
    }
};
struct EpiGlu {
    static constexpr bool PERM = true;
    bf16_t* O; const LAS float* rtab;
    __device__ __forceinline__ void operator()(const f32x4 (&acc)[2][2][4][2], const Unit& u, int wr, int wc, int fr, int fq) const {
        const __amdgpu_buffer_rsrc_t rsrc = __builtin_amdgcn_make_buffer_rsrc(O, 0, XROWS * DFF * 2, 0x00020000);
#pragma unroll
        for (int ai = 0; ai < 2; ++ai)
#pragma unroll
            for (int m = 0; m < 4; ++m) {
                const int rl = ai * HALF + wr * 64 + m * 16 + fr;
                const float rs = rtab[u.idx * 256 + rl];
                bf16_t* rowp = O + (size_t)(rowX_tile(u.pm) + rl) * DFF + u.pn * HALF + wc * 32 + 8 * fq;
                float o[8];
#pragma unroll
                for (int n = 0; n < 2; ++n)
#pragma unroll
                    for (int j = 0; j < 4; ++j) { const float g = acc[ai][0][m][n][j] * rs, up = acc[ai][1][m][n][j] * rs; o[n * 4 + j] = g * up * __builtin_amdgcn_rcpf(1.0f + __builtin_amdgcn_exp2f(g * -1.4426950408889634f)); }
                u32x4 w; w.x = cvt_pk_bf16(o[0], o[1]); w.y = cvt_pk_bf16(o[2], o[3]); w.z = cvt_pk_bf16(o[4], o[5]); w.w = cvt_pk_bf16(o[6], o[7]);
                __builtin_amdgcn_raw_buffer_store_b128(w, rsrc, (int)((rowp - O) * 2), 0, 16);
            }
    }
};
struct EpiRes {
    static constexpr bool PERM = false;
    bf16_t* hb; float* ssq;
    __device__ __forceinline__ void operator()(const f32x4 (&acc)[2][2][4][2], const Unit& u, int wr, int wc, int fr, int fq) const {
#pragma unroll
        for (int ai = 0; ai < 2; ++ai) {
            u32x2 pre[4][2][2];
#pragma unroll
            for (int m = 0; m < 4; ++m) { const size_t offx = (size_t)(rowX_tile(u.pm) + ai * HALF + wr * 64 + m * 16 + fr) * DM + u.pn * BM + wc * 32 + 4 * fq;
#pragma unroll
                for (int bj = 0; bj < 2; ++bj)
#pragma unroll
                    for (int n = 0; n < 2; ++n) pre[m][bj][n] = *(const u32x2*)(hb + offx + bj * HALF + n * 16); }
#pragma unroll
            for (int m = 0; m < 4; ++m) {
                const int rl = ai * HALF + wr * 64 + m * 16 + fr, rowm = u.pm * BM + rl;
                const size_t offx = (size_t)(rowX_tile(u.pm) + rl) * DM + u.pn * BM + wc * 32 + 4 * fq;
                float ss = 0.f;
#pragma unroll
                for (int bj = 0; bj < 2; ++bj)
#pragma unroll
                    for (int n = 0; n < 2; ++n) {
                        const u32x2 p = pre[m][bj][n];
                        const f32x4 v = (f32x4){__uint_as_float(p.x << 16), __uint_as_float(p.x & 0xffff0000u), __uint_as_float(p.y << 16), __uint_as_float(p.y & 0xffff0000u)} + acc[ai][bj][m][n];
                        u32x2 w; w.x = cvt_pk_bf16(v[0], v[1]); w.y = cvt_pk_bf16(v[2], v[3]);
                        *(u32x2*)(hb + offx + bj * HALF + n * 16) = w;
                        const float r0 = __uint_as_float(w.x << 16), r1 = __uint_as_float(w.x & 0xffff0000u), r2 = __uint_as_float(w.y << 16), r3 = __uint_as_float(w.y & 0xffff0000u);
                        ss += (r0 * r0 + r1 * r1) + (r2 * r2 + r3 * r3);
                    }
                ss += __shfl_xor(ss, 16); ss += __shfl_xor(ss, 32);
                if (fq == 0) ssq[(size_t)rowm * 16 + u.pn * 4 + wc] = ss;
            }
        }
    }
};
struct EpiDry {
    static constexpr bool PERM = false;
    float* sink;
    __device__ __forceinline__ void operator()(const f32x4 (&acc)[2][2][4][2], const Unit& u, int wr, int wc, int fr, int fq) const {
        f32x4 t = {0.f, 0.f, 0.f, 0.f};
#pragma unroll
        for (int ai = 0; ai < 2; ++ai)
#pragma unroll
            for (int bj = 0; bj < 2; ++bj)
#pragma unroll
                for (int m = 0; m < 4; ++m)
#pragma unroll
                    for (int n = 0; n < 2; ++n) t += acc[ai][bj][m][n];
        if (t[0] + t[1] + t[2] + t[3] == 1.2345e30f) sink[0] = t[0];
    }
};
template <class Epi, bool ALIGN_EPI, bool SP2>
__device__ __forceinline__ void gemm_phase(LAS unsigned char* lds, const Gemm g, const StaticOrder& S, const Epi& E) {
    const int tid = tidx(), wid = __builtin_amdgcn_readfirstlane(tid >> 6), lane = tid & 63, wr = wid >> 2, wc = wid & 3, fr = lane & 15, fq = lane >> 4;
    const int K = g.K, nt = K / BK, lda = g.lda;
    unsigned voffA[2], voffB[2];
#pragma unroll
    for (int i = 0; i < 2; ++i) { int R, C; stage_rc(tid * 16 + i * 8192, R, C); const int Rb = Epi::PERM ? ((R & ~31) + perm32(R & 31)) : R;
        voffA[i] = (unsigned)(R * lda + C) * 2u; voffB[i] = (unsigned)(Rb * K + C) * 2u; }
    const size_t kstep = (size_t)(BK * 2);
    const size_t hstepA = (size_t)HALF * lda * 2, hstepB = (size_t)HALF * K * 2;
    const size_t tstepB = 2 * hstepB;
    const unsigned ldsw = (unsigned)wid * 1024u;
    const int aoff = lds_byte(wr * 64 + fr, fq * 8), boff = lds_byte(wc * 32 + fr, fq * 8);
#define PG8_SA(b, h) (((b) * 2 + (h)) * HTB)
#define PG8_SB(b, h) ((4 + (b) * 2 + (h)) * HTB)
#define PG8_STAGE(bufoff, gbase, voff) do { _Pragma("unroll") for (int _i = 0; _i < 2; ++_i) \
        __builtin_amdgcn_global_load_lds((const unsigned*)((const char*)(gbase) + (voff)[_i]), (LAS unsigned*)(lds + (bufoff) + ldsw + _i * 8192), 16, 0, 0); } while (0)
#define PG8_LDA(dst, b, h) do { _Pragma("unroll") for (int m = 0; m < 4; ++m) _Pragma("unroll") for (int k = 0; k < 2; ++k) dst[m][k] = *(const LAS bf16x8*)(lds + PG8_SA(b, h) + aoff + m * 2048 + k * 1024); } while (0)
#define PG8_LDB(dst, b, h) do { _Pragma("unroll") for (int n = 0; n < 2; ++n) _Pragma("unroll") for (int k = 0; k < 2; ++k) dst[n][k] = *(const LAS bf16x8*)(lds + PG8_SB(b, h) + boff + n * 2048 + k * 1024); } while (0)
#define PG8_MMA(ai, bj, At, Bt) do { __builtin_amdgcn_s_setprio(1); _Pragma("unroll") for (int m = 0; m < 4; ++m) _Pragma("unroll") for (int n = 0; n < 2; ++n) _Pragma("unroll") for (int k = 0; k < 2; ++k) \
        acc[ai][bj][m][n] = __builtin_amdgcn_mfma_f32_16x16x32_bf16(Bt[n][k], At[m][k], acc[ai][bj][m][n], 0, 0, 0); __builtin_amdgcn_s_setprio(0); } while (0)
#define PG8_WAIT_V(n) asm volatile("s_waitcnt vmcnt(" #n ")" ::: "memory")
#define PG8_WAIT_L(n) asm volatile("s_waitcnt lgkmcnt(" #n ")" ::: "memory")
#define PG8_BAR __builtin_amdgcn_s_barrier()
#define PG8_SCHED __builtin_amdgcn_sched_barrier(0)
    Unit cur, nxt; int ui = 0;
    if (!S.next(0, cur)) return;
    cur.idx = 0;
    f32x4 acc[2][2][4][2];
#pragma unroll
    for (int a = 0; a < 2; ++a)
#pragma unroll
        for (int b = 0; b < 2; ++b)
#pragma unroll
            for (int m = 0; m < 4; ++m)
#pragma unroll
                for (int n = 0; n < 2; ++n) acc[a][b][m][n] = (f32x4){0.f, 0.f, 0.f, 0.f};
    bf16x8 At[4][2], B0[2][2], B1[2][2];
    const char* cA = (const char*)g.A + (size_t)rowX_tile(cur.pm) * lda * 2; const char* cB = (const char*)g.Bt + (size_t)cur.pn * tstepB;
    if constexpr (SP2) {
        PG8_STAGE(PG8_SB(0, 0), cB, voffB); PG8_STAGE(PG8_SB(0, 1), cB + hstepB, voffB); PG8_STAGE(PG8_SA(0, 0), cA, voffA); PG8_STAGE(PG8_SA(0, 1), cA + hstepA, voffA);
        if (wr == 1) PG8_BAR;
        PG8_WAIT_V(2); PG8_BAR;
        PG8_STAGE(PG8_SB(1, 0), cB + kstep, voffB); PG8_STAGE(PG8_SA(1, 0), cA + kstep, voffA); PG8_STAGE(PG8_SB(1, 1), cB + hstepB + kstep, voffB);
        PG8_WAIT_V(6); PG8_BAR;
    } else {
        PG8_STAGE(PG8_SB(0, 0), cB, voffB); PG8_STAGE(PG8_SA(0, 0), cA, voffA); PG8_STAGE(PG8_SB(0, 1), cB + hstepB, voffB); PG8_STAGE(PG8_SA(0, 1), cA + hstepA, voffA);
        if (wr == 1) PG8_BAR;
        PG8_WAIT_V(4); PG8_BAR;
        PG8_STAGE(PG8_SB(1, 0), cB + kstep, voffB); PG8_STAGE(PG8_SA(1, 0), cA + kstep, voffA); PG8_STAGE(PG8_SB(1, 1), cB + hstepB + kstep, voffB);
        PG8_WAIT_V(6); PG8_BAR;
    }
    for (;;) {
        const bool has_next = S.next(ui + 1, nxt); nxt.idx = ui + 1;
        const char* nA = has_next ? (const char*)g.A + (size_t)rowX_tile(nxt.pm) * lda * 2 : cA; const char* nB = has_next ? (const char*)g.Bt + (size_t)nxt.pn * tstepB : cB;
        for (int t = 0; t < nt; t += 2) {
            const bool last = (t == nt - 2);
            const char* a1 = cA + (size_t)(t + 1) * kstep;
            const char* a2 = last ? nA : cA + (size_t)(t + 2) * kstep; const char* b2 = last ? nB : cB + (size_t)(t + 2) * kstep;
            const char* a3 = a2 + kstep; const char* b3 = b2 + kstep;
            if constexpr (SP2) {
            PG8_LDB(B0, 0, 0); PG8_LDB(B1, 0, 1); PG8_SCHED; PG8_LDA(At, 0, 0); PG8_STAGE(PG8_SA(1, 1), a1 + hstepA, voffA);
            PG8_WAIT_V(8); PG8_WAIT_L(0); PG8_BAR; PG8_MMA(0, 0, At, B0); PG8_MMA(0, 1, At, B1); PG8_BAR; PG8_SCHED;
            PG8_LDA(At, 0, 1); PG8_STAGE(PG8_SB(0, 0), b2, voffB); PG8_STAGE(PG8_SB(0, 1), b2 + hstepB, voffB); PG8_STAGE(PG8_SA(0, 0), a2, voffA);
            PG8_WAIT_V(8); PG8_WAIT_L(0); PG8_BAR; PG8_MMA(1, 0, At, B0); PG8_MMA(1, 1, At, B1); PG8_BAR; PG8_SCHED;
            PG8_LDB(B0, 1, 0); PG8_LDB(B1, 1, 1); PG8_SCHED; PG8_LDA(At, 1, 0); PG8_STAGE(PG8_SA(0, 1), a2 + hstepA, voffA);
            PG8_WAIT_V(8); PG8_WAIT_L(0); PG8_BAR; PG8_MMA(0, 0, At, B0); PG8_MMA(0, 1, At, B1); PG8_BAR; PG8_SCHED;
            PG8_LDA(At, 1, 1); PG8_STAGE(PG8_SB(1, 0), b3, voffB); PG8_STAGE(PG8_SB(1, 1), b3 + hstepB, voffB); PG8_STAGE(PG8_SA(1, 0), a3, voffA);
            PG8_WAIT_V(8); PG8_WAIT_L(0); PG8_BAR; PG8_MMA(1, 0, At, B0); PG8_MMA(1, 1, At, B1); PG8_BAR; PG8_SCHED;
            } else {
            PG8_LDB(B0, 0, 0); PG8_SCHED; PG8_LDA(At, 0, 0); PG8_STAGE(PG8_SA(1, 1), a1 + hstepA, voffA);
            PG8_WAIT_L(8); PG8_BAR; PG8_WAIT_L(0); PG8_MMA(0, 0, At, B0); PG8_BAR; PG8_SCHED;
            PG8_LDB(B1, 0, 1); PG8_STAGE(PG8_SB(0, 0), b2, voffB);
            PG8_BAR; PG8_WAIT_L(0); PG8_MMA(0, 1, At, B1); PG8_BAR;
            PG8_LDA(At, 0, 1); PG8_STAGE(PG8_SA(0, 0), a2, voffA);
            PG8_BAR; PG8_WAIT_L(0); PG8_MMA(1, 0, At, B0); PG8_BAR; PG8_SCHED;
            PG8_STAGE(PG8_SB(0, 1), b2 + hstepB, voffB);
            PG8_WAIT_V(6); PG8_BAR; PG8_MMA(1, 1, At, B1); PG8_BAR;
            PG8_LDB(B0, 1, 0); PG8_SCHED; PG8_LDA(At, 1, 0); PG8_STAGE(PG8_SA(0, 1), a2 + hstepA, voffA);
            PG8_WAIT_L(8); PG8_BAR; PG8_WAIT_L(0); PG8_MMA(0, 0, At, B0); PG8_BAR; PG8_SCHED;
            PG8_LDB(B1, 1, 1); PG8_STAGE(PG8_SB(1, 0), b3, voffB);
            PG8_BAR; PG8_WAIT_L(0); PG8_MMA(0, 1, At, B1); PG8_BAR;
            PG8_LDA(At, 1, 1); PG8_STAGE(PG8_SA(1, 0), a3, voffA);
            PG8_BAR; PG8_WAIT_L(0); PG8_MMA(1, 0, At, B0); PG8_BAR; PG8_SCHED;
            PG8_STAGE(PG8_SB(1, 1), b3 + hstepB, voffB);
            PG8_WAIT_V(6); PG8_BAR; PG8_MMA(1, 1, At, B1); PG8_BAR;
            }
        }
        if constexpr (ALIGN_EPI) { if (wr == 0) PG8_BAR; }
        E(acc, cur, wr, wc, fr, fq);
        if (!has_next) break;
#pragma unroll
        for (int a = 0; a < 2; ++a)
#pragma unroll
            for (int b = 0; b < 2; ++b)
#pragma unroll
                for (int m = 0; m < 4; ++m)
#pragma unroll
                    for (int n = 0; n < 2; ++n) acc[a][b][m][n] = (f32x4){0.f, 0.f, 0.f, 0.f};
        cur = nxt; cA = nA; cB = nB; ++ui;
        if constexpr (ALIGN_EPI) { if (wr == 1) PG8_BAR; }
    }
    PG8_WAIT_V(0);
    if constexpr (!ALIGN_EPI) { if (wr == 0) PG8_BAR; }
    PG8_BAR;
#undef PG8_SA
#undef PG8_SB
#undef PG8_STAGE
#undef PG8_LDA
#undef PG8_LDB
#undef PG8_MMA
#undef PG8_WAIT_V
#undef PG8_WAIT_L
#undef PG8_BAR
#undef PG8_SCHED
}
}

#define XB_TMO      128
#define XB_XCNT(j)  (256  + 64 * (j))
#define XB_XSUB(j)  (1280 + 64 * (j))
#define XB_XGEN(j)  (2304 + 64 * (j))
#define XB_TOP      3328
#define XB_TOPGEN   3392
#define XCD_BAR_WORDS 3456
#define XB_SPIN_CAP (1u << 18)

__device__ __forceinline__ unsigned xb_ld(unsigned* p)              { return __hip_atomic_load(p, __ATOMIC_RELAXED, __HIP_MEMORY_SCOPE_AGENT); }
__device__ __forceinline__ unsigned xb_add(unsigned* p, unsigned v) { return __hip_atomic_fetch_add(p, v, __ATOMIC_RELAXED, __HIP_MEMORY_SCOPE_AGENT); }
__device__ __forceinline__ unsigned xb_xcc_id() { return (unsigned)__builtin_amdgcn_s_getreg((3 << 11) | 20) & 0xFu; }
#define XB_SPIN(cond, bar) do { unsigned _sp = 0; while (cond) { \
    if ((++_sp & 255u) == 0u) { if (xb_ld(&(bar)[XB_TMO])) break; if (_sp > XB_SPIN_CAP) { atomicAdd(&(bar)[XB_TMO], 1u); break; } } } } while (0)

struct XcdBarrier {
    unsigned* bar; unsigned x;
    volatile LAS unsigned* st;
};

__device__ __forceinline__ XcdBarrier xcd_barrier_post(unsigned* bar, volatile LAS unsigned* st) {
    XcdBarrier b; b.bar = bar; b.x = xb_xcc_id(); b.st = st;
    if (threadIdx.x == 0) (void)xb_add(&bar[XB_XCNT(b.x)], 1u);
    return b;
}
__device__ __forceinline__ void xcd_barrier_complete(unsigned* bar, unsigned x, unsigned& nloc, unsigned& nx) {
    const unsigned G = gridDim.x * gridDim.y * gridDim.z;
    unsigned sum, cnt, mine, sp = 0u;
    for (;;) {
        sum = 0u; cnt = 0u; mine = 0u;
#pragma unroll
        for (unsigned j = 0; j < 16; ++j) { const unsigned c = xb_ld(&bar[XB_XCNT(j)]); sum += c; cnt += (c > 0u) ? 1u : 0u; mine = (j == x) ? c : mine; }
        if (sum == G) break;
        __builtin_amdgcn_s_sleep(1);
        if ((++sp & 255u) == 0u) { if (xb_ld(&bar[XB_TMO])) break; if (sp > XB_SPIN_CAP) { atomicAdd(&bar[XB_TMO], 1u); break; } }
    }
    nloc = mine > 0u ? mine : 1u; nx = cnt > 0u ? cnt : 1u;
}

__device__ __forceinline__ void xcd_barrier(const XcdBarrier& b) {
    asm volatile("s_waitcnt vmcnt(0)" ::: "memory");
    __syncthreads();
    if (threadIdx.x == 0) {
        unsigned* bar = b.bar;
        __builtin_amdgcn_s_waitcnt(0);
        unsigned nloc = b.st[0], nx = b.st[1];
        if (nloc == 0u) { xcd_barrier_complete(bar, b.x, nloc, nx); b.st[0] = nloc; b.st[1] = nx; }
        const unsigned old = xb_add(&bar[XB_XSUB(b.x)], 1u);
        const unsigned gen = old / nloc;
        if (old + 1u == (gen + 1u) * nloc) {
            __builtin_amdgcn_fence(__ATOMIC_RELEASE, "agent");
            asm volatile("s_waitcnt vmcnt(0)" ::: "memory");
            const unsigned og = xb_add(&bar[XB_TOP], 1u);
            const unsigned tg = og / nx;
            if (og + 1u == (tg + 1u) * nx) xb_add(&bar[XB_TOPGEN], 1u);
            else XB_SPIN(xb_ld(&bar[XB_TOPGEN]) == tg, bar);
            __builtin_amdgcn_fence(__ATOMIC_ACQUIRE, "agent");
            xb_add(&bar[XB_XGEN(b.x)], 1u);
            asm volatile("s_waitcnt vmcnt(0)" ::: "memory");
        } else {
            XB_SPIN(xb_ld(&bar[XB_XGEN(b.x)]) == gen, bar);
            __builtin_amdgcn_fence(__ATOMIC_ACQUIRE, "agent");
            asm volatile("s_waitcnt vmcnt(0)" ::: "memory");
        }
    }
    __syncthreads();
}


struct Args { const float* in[19]; float* out; unsigned char* ws; int ph_lo, ph_hi; };
typedef const __attribute__((address_space(4))) Args* CArgsP;
__device__ __forceinline__ CArgsP kargs() { CArgsP p = (CArgsP)__builtin_amdgcn_kernarg_segment_ptr(); asm volatile("" : "+s"(p)); return p; }
#define KA (kargs())
enum { I_X = 0, I_META, I_NMIX, I_WIN, I_CONVW, I_CONVB, I_GAW, I_GAB, I_GXW, I_GXB, I_LAM, I_LRUN, I_RETN, I_WOUT, I_NFFN, I_WG, I_WU, I_WD, I_NFIN };

#define LDS_WAIT() asm volatile("s_waitcnt lgkmcnt(0)" ::: "memory")

struct TrDesc { const float* W; const float* gain; bf16_t* WT; int K, N, kind, k0, n0; };
__device__ __forceinline__ TrDesc tr_desc(int it) {
    constexpr int I_IN = (DM / 64) * (DIN / 32), I_OUT = (DM / 64) * (DM / 32), I_G = (DM / 64) * (DFF / 32);
    constexpr int PER_LAYER = I_IN + I_OUT + 2 * I_G + (DFF / 64) * (DM / 32);
    const int l = it / PER_LAYER; int r = it % PER_LAYER;
    bf16_t* wl = (bf16_t*)(KA->ws + WS_W) + (size_t)l * W_LAYER_E;
    TrDesc d;
    if (r < I_IN) { d.W = KA->in[I_WIN] + (size_t)l * DM * DIN; d.gain = KA->in[I_NMIX] + l * DM; d.WT = wl; d.K = DM; d.N = DIN; d.kind = 0; }
    else if ((r -= I_IN) < I_OUT) { d.W = KA->in[I_WOUT] + (size_t)l * DM * DM; d.gain = nullptr; d.WT = wl + W_IN_E; d.K = DM; d.N = DM; d.kind = 1; }
    else if ((r -= I_OUT) < I_G) { d.W = KA->in[I_WG] + (size_t)l * DM * DFF; d.gain = KA->in[I_NFFN] + l * DM; d.WT = wl + W_IN_E + W_OUT_E; d.K = DM; d.N = DFF; d.kind = 2; }
    else if ((r -= I_G) < I_G) { d.W = KA->in[I_WU] + (size_t)l * DM * DFF; d.gain = KA->in[I_NFFN] + l * DM; d.WT = wl + W_IN_E + W_OUT_E; d.K = DM; d.N = DFF; d.kind = 3; }
    else { r -= I_G; d.W = KA->in[I_WD] + (size_t)l * DFF * DM; d.gain = nullptr; d.WT = wl + W_IN_E + W_OUT_E + W_GU_E; d.K = DFF; d.N = DM; d.kind = 1; }
    const int nblk = d.N / 32; d.k0 = 64 * (r / nblk); d.n0 = 32 * (r % nblk);
    return d;
}
__device__ __forceinline__ void tr_load(const TrDesc& d, float (&v)[32], int lane) {
    const float* wp = d.W + (size_t)(d.k0 + (lane >> 5)) * d.N + d.n0 + (lane & 31);
#pragma unroll
    for (int i = 0; i < 32; ++i) v[i] = wp[(size_t)(2 * i) * d.N];
}
__device__ __forceinline__ void tr_emit(const TrDesc& d, const float (&v)[32], LAS float* scr, int lane) {
    const int c = lane & 7;
    f32x4 g0 = {1.f, 1.f, 1.f, 1.f}, g1 = {1.f, 1.f, 1.f, 1.f};
    if (d.gain) { g0 = *(const f32x4*)(d.gain + d.k0 + 8 * c); g1 = *(const f32x4*)(d.gain + d.k0 + 8 * c + 4); }
#pragma unroll
    for (int i = 0; i < 32; ++i) scr[(2 * i + (lane >> 5)) * 33 + (lane & 31)] = v[i];
    LDS_WAIT(); asm volatile("" ::: "memory");
#pragma unroll
    for (int j = 0; j < 4; ++j) {
        const int n = (lane >> 3) + 8 * j, ncol = d.n0 + n; int dest = ncol; float sc = 1.0f;
        if (d.kind == 0) { const int reg = ncol >> 9, r = ncol & 511, hh = r >> 7, dd = r & 127, p = 2 * (dd & 63) + (dd >> 6);
            if (reg == 0) dest = C_XL + r; else if (reg == 1) dest = C_GL + r; else if (reg == 2) dest = C_Q + 128 * hh + p;
            else if (reg == 3) { dest = C_K + 128 * hh + p; sc = 0.08838834764831845f; } else if (reg == 4) dest = C_V + r; else dest = C_GR + r; }
        else if (d.kind == 2) dest = (ncol >> 7) * 256 + (ncol & 127);
        else if (d.kind == 3) dest = (ncol >> 7) * 256 + 128 + (ncol & 127);
        const LAS float* s = scr + (8 * c) * 33 + n;
        u32x4 o; o.x = pk2(s[0 * 33] * (g0[0] * sc), s[1 * 33] * (g0[1] * sc)); o.y = pk2(s[2 * 33] * (g0[2] * sc), s[3 * 33] * (g0[3] * sc));
        o.z = pk2(s[4 * 33] * (g1[0] * sc), s[5 * 33] * (g1[1] * sc)); o.w = pk2(s[6 * 33] * (g1[2] * sc), s[7 * 33] * (g1[3] * sc));
        *(u32x4*)(d.WT + (size_t)dest * d.K + d.k0 + 8 * c) = o;
    }
    LDS_WAIT(); asm volatile("" ::: "memory");
}

__device__ __forceinline__ void prologue(LAS unsigned char* lds, int G) {
    const int tid = tidx(), lane = tid & 63, wave = __builtin_amdgcn_readfirstlane(tid >> 6);
    LAS float* scr = (LAS float*)(lds + wave * 16384);
    const int gw = bidx() * 8 + wave, NGW = G * 8;
    {
        constexpr int TOTAL = ((DM / 64) * (DIN / 32) + (DM / 64) * (DM / 32) + 2 * (DM / 64) * (DFF / 32) + (DFF / 64) * (DM / 32)) * DEPTH;
        float va[32], vb[32]; TrDesc da, db;
        int it = gw;
        if (it < TOTAL) { da = tr_desc(it); tr_load(da, va, lane); }
        while (it < TOTAL) {
            int nx = it + NGW;
            if (nx < TOTAL) { db = tr_desc(nx); tr_load(db, vb, lane); }
            tr_emit(da, va, scr, lane);
            it = nx; nx = it + NGW;
            if (it < TOTAL) { if (nx < TOTAL) { da = tr_desc(nx); tr_load(da, va, lane); } tr_emit(db, vb, scr, lane); it = nx; }
        }
    }
    const float* x = KA->in[I_X]; bf16_t* HB = (bf16_t*)(KA->ws + WS_HB); float* ssq = (float*)(KA->ws + WS_SSQ);
    for (int m0 = gw; m0 < MROWS; m0 += 2 * NGW) {
        f32x4 v[2][4];
#pragma unroll
        for (int q = 0; q < 2; ++q) { const int m = m0 + q * NGW; if (m < MROWS) { const f32x4* xr = (const f32x4*)(x + (size_t)m * DM) + lane;
#pragma unroll
            for (int j = 0; j < 4; ++j) v[q][j] = xr[64 * j]; } }
#pragma unroll
        for (int q = 0; q < 2; ++q) { const int m = m0 + q * NGW; if (m < MROWS) {
            float s = 0.f;
#pragma unroll
            for (int j = 0; j < 4; ++j) s += (v[q][j][0] * v[q][j][0] + v[q][j][1] * v[q][j][1]) + (v[q][j][2] * v[q][j][2] + v[q][j][3] * v[q][j][3]);
            s = wave_sum(s);
            u32x2* o = (u32x2*)(HB + (size_t)rowX(m) * DM) + lane;
#pragma unroll
            for (int j = 0; j < 4; ++j) { u32x2 w; w.x = pk2(v[q][j][0], v[q][j][1]); w.y = pk2(v[q][j][2], v[q][j][3]); o[64 * j] = w; }
            if (lane < 16) ssq[(size_t)m * 16 + lane] = (lane == 0) ? s : 0.f; } }
    }
    const int gt = bidx() * NTHREADS + tid, NGT = G * NTHREADS;
    f32x2* rope = (f32x2*)(KA->ws + WS_ROPE);
    for (int i = gt; i < TT * 64; i += NGT) {
        const int pos = i >> 6, f = i & 63;
        const double rev = (double)pos * INVF[f] * 0.15915494309189535;
        const float fr = (float)(rev - floor(rev));
        rope[i] = (f32x2){__builtin_amdgcn_cosf(fr), __builtin_amdgcn_sinf(fr)};
    }
    { bf16_t* wax = (bf16_t*)(KA->ws + WS_WAX);
      for (int i = gt; i < DEPTH * 8 * 2 * 64 * 64; i += NGT) { const int ii = i & 63, j = (i >> 6) & 63, which = (i >> 12) & 1, lg8 = i >> 13;
          const float* src = which ? KA->in[I_GXW] : KA->in[I_GAW]; wax[i] = (bf16_t)f2bf(-1.4426950408889634f * src[((size_t)lg8 * 64 + ii) * 64 + j]); } }
    float* HM = (float*)(KA->ws + WS_HM);
    for (int i = gt; i < NMETA * DM; i += NGT) HM[i] = KA->in[I_META][i];
}

template <int MODE, int K>
__device__ __forceinline__ void skinny_item(LAS unsigned char* lds, int item, const float* HMr, const bf16_t* Abf, int lda, const bf16_t* Bt, float* HMw, bf16_t* Obf, const f32x2* rope) {
    const int tid = tidx(), lane = tid & 63, wave = __builtin_amdgcn_readfirstlane(tid >> 6), fr = lane & 15, fq = lane >> 4;
    const int n0 = item * 16;
    int brow = n0 + fr; if (MODE == 2) brow = (n0 >> 7) * 256 + (n0 & 127) + fr;
    constexpr int kper = K / 8, KSTEPS = kper / 32; const int kbeg = wave * kper;
    f32x4 acc = {0.f, 0.f, 0.f, 0.f}, acc2 = {0.f, 0.f, 0.f, 0.f}; float ss = 0.f;
    const int colE = n0 + 4 * fq;
    f32x4 hmv = {0.f, 0.f, 0.f, 0.f}; f32x2 rc0 = {1.f, 0.f}, rc1 = {1.f, 0.f};
    if (MODE == 1) hmv = *(const f32x4*)(HMw + (size_t)fr * DM + colE);
    if (MODE == 0 && colE >= C_Q && colE < C_GL) { const int i0 = (colE & 127) >> 1; rc0 = rope[fr * 64 + i0]; rc1 = rope[fr * 64 + i0 + 1]; }
    bf16x8 bq[KSTEPS], bq2[KSTEPS], aq[KSTEPS]; f32x4 au[KSTEPS], av[KSTEPS];
#pragma unroll
    for (int st = 0; st < KSTEPS; ++st) { const int k0 = kbeg + 32 * st;
        if (MODE == 1) aq[st] = *(const bf16x8*)(Abf + (size_t)fr * lda + k0 + 8 * fq);
        else { const f32x4* p = (const f32x4*)(HMr + (size_t)fr * DM + k0 + 8 * fq); au[st] = p[0]; av[st] = p[1]; }
        bq[st] = *(const bf16x8*)(Bt + (size_t)brow * K + k0 + 8 * fq);
        if (MODE == 2) bq2[st] = *(const bf16x8*)(Bt + (size_t)(brow + 128) * K + k0 + 8 * fq); }
    __builtin_amdgcn_sched_barrier(0);
#pragma unroll
    for (int st = 0; st < KSTEPS; ++st) {
        bf16x8 af;
        if (MODE == 1) af = aq[st];
        else { const f32x4 u = au[st], v = av[st];
            ss += (u[0] * u[0] + u[1] * u[1]) + (u[2] * u[2] + u[3] * u[3]) + (v[0] * v[0] + v[1] * v[1]) + (v[2] * v[2] + v[3] * v[3]);
            u32x4 w; w.x = pk2(u[0], u[1]); w.y = pk2(u[2], u[3]); w.z = pk2(v[0], v[1]); w.w = pk2(v[2], v[3]); af = __builtin_bit_cast(bf16x8, w); }
        acc = __builtin_amdgcn_mfma_f32_16x16x32_bf16(bq[st], af, acc, 0, 0, 0);
        if (MODE == 2) acc2 = __builtin_amdgcn_mfma_f32_16x16x32_bf16(bq2[st], af, acc2, 0, 0, 0);
    }
    ss += __shfl_xor(ss, 16); ss += __shfl_xor(ss, 32);
    LAS float* red = (LAS float*)lds;
    LAS float* mine = red + (wave * 64 + lane) * 9;
    mine[0] = acc[0]; mine[1] = acc[1]; mine[2] = acc[2]; mine[3] = acc[3]; mine[4] = acc2[0]; mine[5] = acc2[1]; mine[6] = acc2[2]; mine[7] = acc2[3]; mine[8] = ss;
    __syncthreads();
    if (wave == 0) {
        float r[9];
#pragma unroll
        for (int q = 0; q < 9; ++q) { float s = 0.f;
#pragma unroll
            for (int w = 0; w < 8; ++w) s += red[(w * 64 + lane) * 9 + q]; r[q] = s; }
        const float rs = rsqrtf(r[8] * (1.0f / DM) + EPS);
        const int col = n0 + 4 * fq;
        if (MODE == 0) {
            float v0 = r[0] * rs, v1 = r[1] * rs, v2 = r[2] * rs, v3 = r[3] * rs;
            if (col >= C_Q && col < C_GL) { const f32x2 c0 = rc0, c1 = rc1;
                const float a0 = v0, a1 = v1, a2 = v2, a3 = v3; v0 = a0 * c0[0] - a1 * c0[1]; v1 = a0 * c0[1] + a1 * c0[0]; v2 = a2 * c1[0] - a3 * c1[1]; v3 = a2 * c1[1] + a3 * c1[0]; }
            u32x2 w; w.x = pk2(v0, v1); w.y = pk2(v2, v3);
#pragma unroll
            for (int b = 0; b < NB; ++b) *(u32x2*)(Obf + (size_t)(b * TT + fr) * DIN + col) = w;
        } else if (MODE == 1) {
            f32x4* p = (f32x4*)(HMw + (size_t)fr * DM + col); f32x4 v = hmv; v[0] += r[0]; v[1] += r[1]; v[2] += r[2]; v[3] += r[3]; *p = v;
        } else {
            float o[4];
#pragma unroll
            for (int j = 0; j < 4; ++j) { const float g = r[j] * rs, up = r[4 + j] * rs; o[j] = g * up * __builtin_amdgcn_rcpf(1.0f + __builtin_amdgcn_exp2f(g * -1.4426950408889634f)); }
            u32x2 w; w.x = pk2(o[0], o[1]); w.y = pk2(o[2], o[3]);
            *(u32x2*)(Obf + (size_t)fr * DFF + col) = w;
        }
    }
    __syncthreads();
}

constexpr int XS = 516;
constexpr int TS = 140;
constexpr int SS = 136;
__device__ __forceinline__ bf16x8 ld_lds_2x8(const LAS bf16_t* p0, const LAS bf16_t* p1) { const u32x2 a = *(const LAS u32x2*)p0, b = *(const LAS u32x2*)p1; u32x4 w; w.x = a.x; w.y = a.y; w.z = b.x; w.w = b.y; return __builtin_bit_cast(bf16x8, w); }
__device__ __forceinline__ f32x4 mfma16(bf16x8 a, bf16x8 b, f32x4 c) { return __builtin_amdgcn_mfma_f32_16x16x32_bf16(a, b, c, 0, 0, 0); }

__device__ __forceinline__ u32x4* lc_item(int b, int c, int g, int nt, int mt, int lane) {
    unsigned char* base = (unsigned char*)KA->out + 16 * MiB + (size_t)b * LC_BATCH;
    return (u32x4*)base + ((((size_t)c * 8 + g) * 4 + nt) * 4 + mt) * 64 + lane;
}
__device__ __forceinline__ void lru_unit(LAS unsigned char* lds, int l, int b, int c, bool full, bool nostore = false, bool ldsc = false) {
    const int tid = tidx(), lane = tid & 63, wave = __builtin_amdgcn_readfirstlane(tid >> 6), fr = lane & 15, fq = lane >> 4;
    const int t0 = c == 0 ? 0 : NMETA + 64 * (c - 1), ntok = c == 0 ? NMETA : 64, nmt = ntok >> 4;
    LAS float* xcL = (LAS float*)lds;
    LAS float* part = xcL + 64 * XS;
    bf16_t* P = (bf16_t*)(KA->ws + WS_PROJ) + (size_t)b * TT * DIN;
    bf16x8 wfr[4][4]; float bav[4], bxv[4], c2v[4];
    if (!full) {
        const bf16_t* wt0 = (const bf16_t*)(KA->ws + WS_WAX) + (size_t)(l * 8 + wave) * 2 * 64 * 64;
#pragma unroll
        for (int nt = 0; nt < 4; ++nt) {
            const bf16_t* wr = wt0 + (size_t)(16 * nt + fr) * 64 + 8 * fq;
            wfr[nt][0] = *(const bf16x8*)wr; wfr[nt][1] = *(const bf16x8*)(wr + 32); wfr[nt][2] = *(const bf16x8*)(wr + 64 * 64); wfr[nt][3] = *(const bf16x8*)(wr + 64 * 64 + 32);
            const int chn = l * DLRU + 64 * wave + 16 * nt + fr;
            bav[nt] = -1.4426950408889634f * KA->in[I_GAB][chn]; bxv[nt] = -1.4426950408889634f * KA->in[I_GXB][chn];
            c2v[nt] = -8.0f * 1.4426950408889634f * log1pf(__expf(-KA->in[I_LAM][chn]));
        }
    }
    u32x4 gr[8]; f32x4 og0 = {0.f, 0.f, 0.f, 0.f}, og1 = {0.f, 0.f, 0.f, 0.f};
    if (full && 8 * wave < ntok) {
#pragma unroll
        for (int i = 0; i < 8; ++i) gr[i] = *(const u32x4*)(P + (size_t)(t0 + 8 * wave + i) * DIN + C_GL + 8 * lane);
        const float* ogp = KA->in[I_LRUN] + l * DLRU + 8 * lane; og0 = *(const f32x4*)ogp; og1 = *(const f32x4*)(ogp + 4);
    }
    if (!full) {
        const int tb = 8 * wave, cb8 = 8 * lane;
        if (tb < ntok) {
            u32x4 xr[11];
#pragma unroll
            for (int i = 0; i < 11; ++i) { const int t = t0 + tb + i - 3; xr[i] = (u32x4){0u, 0u, 0u, 0u}; if (t >= 0) xr[i] = *(const u32x4*)(P + (size_t)t * DIN + C_XL + cb8); }
            const float* cw = KA->in[I_CONVW] + (size_t)l * 4 * DLRU + cb8; const float* cbp = KA->in[I_CONVB] + l * DLRU + cb8;
            f32x4 wv[4][2], cbv[2];
#pragma unroll
            for (int k = 0; k < 4; ++k) { wv[k][0] = *(const f32x4*)(cw + k * DLRU); wv[k][1] = *(const f32x4*)(cw + k * DLRU + 4); }
            cbv[0] = *(const f32x4*)cbp; cbv[1] = *(const f32x4*)(cbp + 4);
#pragma unroll
            for (int i = 0; i < 8; ++i) {
                f32x4 o0 = cbv[0], o1 = cbv[1];
#pragma unroll
                for (int k = 0; k < 4; ++k) { const u32x4 w = xr[i + k];
                    const f32x4 a0 = {__uint_as_float(w.x << 16), __uint_as_float(w.x & 0xffff0000u), __uint_as_float(w.y << 16), __uint_as_float(w.y & 0xffff0000u)};
                    const f32x4 a1 = {__uint_as_float(w.z << 16), __uint_as_float(w.z & 0xffff0000u), __uint_as_float(w.w << 16), __uint_as_float(w.w & 0xffff0000u)};
                    o0 += a0 * wv[k][0]; o1 += a1 * wv[k][1]; }
                LAS float* dst = xcL + (tb + i) * XS + cb8; *(LAS f32x4*)dst = o0; *(LAS f32x4*)(dst + 4) = o1;
            }
        }
    }
    __syncthreads();
    const int g = wave;
    bf16x8 xa[4][2];
#pragma unroll
    for (int mt = 0; mt < 4; ++mt)
#pragma unroll
        for (int ks = 0; ks < 2; ++ks) {
            u32x4 w = {0u, 0u, 0u, 0u};
            if (!full && mt < nmt) { const LAS float* p = xcL + (16 * mt + fr) * XS + 64 * g + 32 * ks + 8 * fq; const f32x4 u = *(const LAS f32x4*)p, v = *(const LAS f32x4*)(p + 4);
                w.x = pk2(u[0], u[1]); w.y = pk2(u[2], u[3]); w.z = pk2(v[0], v[1]); w.w = pk2(v[2], v[3]); }
            xa[mt][ks] = __builtin_bit_cast(bf16x8, w);
        }
#pragma unroll
    for (int nt = 0; nt < 4; ++nt) {
        const int ch = 64 * g + 16 * nt + fr;
        const size_t sidx = ((size_t)b * NLC + c) * DLRU + ch;
        float h0 = 0.f, Lacc = 0.f;
        if (!full) {
            const bf16x8 wa0 = wfr[nt][0], wa1 = wfr[nt][1], wx0 = wfr[nt][2], wx1 = wfr[nt][3];
            const float ba = bav[nt], bx = bxv[nt], c2 = c2v[nt];
#pragma unroll
            for (int mt = 0; mt < 4; ++mt) {
                if (mt < nmt) {
                    f32x4 pa = {0.f, 0.f, 0.f, 0.f}, px = {0.f, 0.f, 0.f, 0.f};
                    pa = mfma16(xa[mt][0], wa0, pa); pa = mfma16(xa[mt][1], wa1, pa);
                    px = mfma16(xa[mt][0], wx0, px); px = mfma16(xa[mt][1], wx1, px);
                    float laf[4], ig[4];
#pragma unroll
                    for (int r = 0; r < 4; ++r) {
                        const float ea = 1.0f + __builtin_amdgcn_exp2f(fminf(pa[r] + ba, 57.f)), ex = 1.0f + __builtin_amdgcn_exp2f(fminf(px[r] + bx, 57.f)), inv = frcp(ea * ex);
                        laf[r] = c2 * (ex * inv); ig[r] = ea * inv;
                    }
                    u32x4 cv; cv.x = pg8::cvt_pk_bf16(laf[0], laf[1]); cv.y = pg8::cvt_pk_bf16(laf[2], laf[3]);
                    const float la[4] = {__uint_as_float(cv.x << 16), __uint_as_float(cv.x & 0xffff0000u), __uint_as_float(cv.y << 16), __uint_as_float(cv.y & 0xffff0000u)};
                    float av[4], bbf[4];
#pragma unroll
                    for (int r = 0; r < 4; ++r) { av[r] = __builtin_amdgcn_exp2f(la[r]); bbf[r] = __builtin_amdgcn_sqrtf(fmaxf(1.0f - av[r] * av[r], 0.f)) * ig[r] * xcL[(16 * mt + 4 * fq + r) * XS + ch]; }
                    cv.z = pg8::cvt_pk_bf16(bbf[0], bbf[1]); cv.w = pg8::cvt_pk_bf16(bbf[2], bbf[3]);
                    if (ldsc) { LAS unsigned* cw = (LAS unsigned*)xcL + (16 * mt + 4 * fq) * XS + ch;
                        cw[0] = (cv.x & 0xffffu) | (cv.z << 16); cw[XS] = (cv.x >> 16) | (cv.z & 0xffff0000u); cw[2 * XS] = (cv.y & 0xffffu) | (cv.w << 16); cw[3 * XS] = (cv.y >> 16) | (cv.w & 0xffff0000u); }
                    else *lc_item(b, c, g, nt, mt, lane) = cv;
                    const float bv[4] = {__uint_as_float(cv.z << 16), __uint_as_float(cv.z & 0xffff0000u), __uint_as_float(cv.w << 16), __uint_as_float(cv.w & 0xffff0000u)};
                    float A = 1.f, B = 0.f;
#pragma unroll
                    for (int r = 0; r < 4; ++r) { B = av[r] * B + bv[r]; A = A * av[r]; Lacc += la[r]; }
                    const float pA = __shfl_xor(A, 16), pB = __shfl_xor(B, 16);
                    const float PA = A * pA, PB = (fq & 1) ? A * pB + B : pA * B + pB;
                    const float qA = __shfl_xor(PA, 32), qB = __shfl_xor(PB, 32);
                    const float TA = PA * qA, TB = (fq & 2) ? PA * qB + PB : qA * PB + qB;
                    h0 = TA * h0 + TB;
                }
            }
        } else {
            h0 = ((const float*)(KA->ws + WS_CARRY))[sidx];
            u32x4 cv[4];
#pragma unroll
            for (int mt = 0; mt < 4; ++mt) if (mt < nmt) {
                if (ldsc) { const LAS unsigned* cw = (const LAS unsigned*)xcL + (16 * mt + 4 * fq) * XS + ch; const unsigned w0 = cw[0], w1 = cw[XS], w2 = cw[2 * XS], w3 = cw[3 * XS];
                    cv[mt].x = (w0 & 0xffffu) | (w1 << 16); cv[mt].y = (w2 & 0xffffu) | (w3 << 16); cv[mt].z = (w0 >> 16) | (w1 & 0xffff0000u); cv[mt].w = (w2 >> 16) | (w3 & 0xffff0000u); }
                else cv[mt] = *lc_item(b, c, g, nt, mt, lane);
            }
#pragma unroll
            for (int mt = 0; mt < 4; ++mt) {
                if (mt < nmt) {
                    const float la[4] = {__uint_as_float(cv[mt].x << 16), __uint_as_float(cv[mt].x & 0xffff0000u), __uint_as_float(cv[mt].y << 16), __uint_as_float(cv[mt].y & 0xffff0000u)};
                    const float bv[4] = {__uint_as_float(cv[mt].z << 16), __uint_as_float(cv[mt].z & 0xffff0000u), __uint_as_float(cv[mt].w << 16), __uint_as_float(cv[mt].w & 0xffff0000u)};
                    float Ar[4], Br[4]; float A = 1.f, B = 0.f;
#pragma unroll
                    for (int r = 0; r < 4; ++r) { const float av = __builtin_amdgcn_exp2f(la[r]); B = av * B + bv[r]; A = A * av; Ar[r] = A; Br[r] = B; }
                    const float pA = __shfl_xor(A, 16), pB = __shfl_xor(B, 16);
                    const float PA = A * pA, PB = (fq & 1) ? A * pB + B : pA * B + pB;
                    const float qA = __shfl_xor(PA, 32), qB = __shfl_xor(PB, 32);
                    float hin = h0;
                    if (fq & 2) hin = qA * hin + qB;
                    if (fq & 1) hin = pA * hin + pB;
                    const float TA = PA * qA, TB = (fq & 2) ? PA * qB + PB : qA * PB + qB;
                    h0 = TA * h0 + TB;
#pragma unroll
                    for (int r = 0; r < 4; ++r) xcL[(16 * mt + 4 * fq + r) * XS + ch] = Br[r] + Ar[r] * hin;
                }
            }
        }
        if (!full) {
            Lacc += __shfl_xor(Lacc, 16); Lacc += __shfl_xor(Lacc, 32);
            if (fq == 0) { ((float*)(KA->ws + WS_SUMH))[sidx] = h0; ((float*)(KA->ws + WS_SUML))[sidx] = Lacc; }
        }
    }
    if (full) {
        __syncthreads();
        const int tb = 8 * wave, cb8 = 8 * lane;
        if (tb < ntok) {
#pragma unroll
            for (int i = 0; i < 8; ++i) {
                const LAS float* hp = xcL + (tb + i) * XS + cb8; const f32x4 h0v = *(const LAS f32x4*)hp, h1v = *(const LAS f32x4*)(hp + 4);
                const u32x4 w = gr[i];
                float y[8];
                y[0] = h0v[0] * gelu_tanh(__uint_as_float(w.x << 16)); y[1] = h0v[1] * gelu_tanh(__uint_as_float(w.x & 0xffff0000u));
                y[2] = h0v[2] * gelu_tanh(__uint_as_float(w.y << 16)); y[3] = h0v[3] * gelu_tanh(__uint_as_float(w.y & 0xffff0000u));
                y[4] = h1v[0] * gelu_tanh(__uint_as_float(w.z << 16)); y[5] = h1v[1] * gelu_tanh(__uint_as_float(w.z & 0xffff0000u));
                y[6] = h1v[2] * gelu_tanh(__uint_as_float(w.w << 16)); y[7] = h1v[3] * gelu_tanh(__uint_as_float(w.w & 0xffff0000u));
                float ss = ((y[0] * y[0] + y[1] * y[1]) + (y[2] * y[2] + y[3] * y[3])) + ((y[4] * y[4] + y[5] * y[5]) + (y[6] * y[6] + y[7] * y[7]));
                ss = wave_sum(ss);
                const float rs = __builtin_amdgcn_rsqf(ss * (1.0f / DLRU) + EPS);
                u32x4 o; o.x = pk2(y[0] * rs * og0[0], y[1] * rs * og0[1]); o.y = pk2(y[2] * rs * og0[2], y[3] * rs * og0[3]); o.z = pk2(y[4] * rs * og1[0], y[5] * rs * og1[1]); o.w = pk2(y[6] * rs * og1[2], y[7] * rs * og1[3]);
                if (!nostore) *(u32x4*)(P + (size_t)(t0 + tb + i) * DIN + C_GL + cb8) = o;
            }
        }
    }
    __syncthreads();
}

__device__ __forceinline__ float lg2gamma(int h) { return log2f(1.0f - exp2f(-5.0f - (float)h)); }

constexpr int RS = 144;
typedef short s16x4 __attribute__((ext_vector_type(4)));
template <bool SCALE>
__device__ __forceinline__ void stage_R(LAS bf16_t* img, const bf16_t* P, int t0, int ntok, int col0, float lg, int cpos0, int tid) {
#pragma unroll
    for (int i = 0; i < 4; ++i) {
        const int idx = tid + NTHREADS * i, t = idx >> 4, cc = idx & 15;
        u32x4 w = {0u, 0u, 0u, 0u};
        if (t < ntok) w = *(const u32x4*)(P + (size_t)(t0 + t) * DIN + col0 + 8 * cc);
        if (SCALE) { const float sc = exp2f((float)(127 - (cpos0 + t)) * lg);
#pragma unroll
            for (int q = 0; q < 4; ++q) w[q] = pk2(__uint_as_float(w[q] << 16) * sc, __uint_as_float(w[q] & 0xffff0000u) * sc); }
        *(LAS u32x4*)(img + t * RS + 8 * cc) = w;
    }
}
__device__ __forceinline__ bf16x8 ld_tr(const LAS bf16_t* img, int r0, int r1, int d0, int fr) {
    const int q = fr >> 2, c4 = 4 * (fr & 3);
    const s16x4 x = __builtin_amdgcn_ds_read_tr16_b64_v4i16((LAS s16x4*)(img + (r0 + q) * RS + d0 + c4));
    const s16x4 y = __builtin_amdgcn_ds_read_tr16_b64_v4i16((LAS s16x4*)(img + (r1 + q) * RS + d0 + c4));
    return (bf16x8){x[0], x[1], x[2], x[3], y[0], y[1], y[2], y[3]};
}

struct KvRegs { u32x4 v[4], k[4]; };
__device__ __forceinline__ void kv_issue(KvRegs& R, int b, int n, int h, int tid) {
    const int t0 = n == 0 ? 0 : NMETA + 128 * (n - 1), ntok = n == 0 ? NMETA : 128;
    const bf16_t* P = (const bf16_t*)(KA->ws + WS_PROJ) + (size_t)b * TT * DIN;
#pragma unroll
    for (int i = 0; i < 4; ++i) { const int idx = tid + NTHREADS * i, t = idx >> 4, cc = idx & 15;
        R.v[i] = (u32x4){0u, 0u, 0u, 0u}; R.k[i] = (u32x4){0u, 0u, 0u, 0u};
        if (t < ntok) { const bf16_t* rp = P + (size_t)(t0 + t) * DIN + 128 * h + 8 * cc; R.v[i] = *(const u32x4*)(rp + C_V); R.k[i] = *(const u32x4*)(rp + C_K); } }
}
__device__ __forceinline__ void ret_kv_unit(LAS unsigned char* lds, int b, int n, int h, KvRegs& R, bool has_next, int nb, int nn, int nh) {
    const int tid = tidx(), lane = tid & 63, wave = __builtin_amdgcn_readfirstlane(tid >> 6), fr = lane & 15, fq = lane >> 4;
    const int ntok = n == 0 ? NMETA : 128, cpos0 = n == 0 ? 112 : 0;
    const float lg = lg2gamma(h);
    LAS bf16_t* vI = (LAS bf16_t*)lds; LAS bf16_t* kI = vI + 128 * RS;
#pragma unroll
    for (int i = 0; i < 4; ++i) { const int idx = tid + NTHREADS * i, t = idx >> 4, cc = idx & 15;
        *(LAS u32x4*)(vI + t * RS + 8 * cc) = R.v[i];
        const float sc = exp2f((float)(127 - (cpos0 + t)) * lg); u32x4 w = R.k[i];
#pragma unroll
        for (int q = 0; q < 4; ++q) w[q] = pk2(__uint_as_float(w[q] << 16) * sc, __uint_as_float(w[q] & 0xffff0000u) * sc);
        *(LAS u32x4*)(kI + t * RS + 8 * cc) = w; }
    __syncthreads();
    if (has_next) kv_issue(R, nb, nn, nh, tid);
    f32x4 acc[8];
#pragma unroll
    for (int dt = 0; dt < 8; ++dt) acc[dt] = (f32x4){0.f, 0.f, 0.f, 0.f};
    const int nkt = (ntok + 31) >> 5;
    for (int kt = 0; kt < nkt; ++kt) {
        const int r0 = 32 * kt + 8 * fq;
        const bf16x8 vf = ld_tr(vI, r0, r0 + 4, 16 * wave, fr);
#pragma unroll
        for (int dt = 0; dt < 8; ++dt) acc[dt] = mfma16(ld_tr(kI, r0, r0 + 4, 16 * dt, fr), vf, acc[dt]);
    }
    bf16_t* S = (bf16_t*)KA->out + ((size_t)((b * NH + h) * 16 + n)) * 16384 + (size_t)(16 * wave + fr) * 128 + 4 * fq;
#pragma unroll
    for (int dt = 0; dt < 8; ++dt) { u32x2 w; w.x = pk2(acc[dt][0], acc[dt][1]); w.y = pk2(acc[dt][2], acc[dt][3]); *(u32x2*)(S + 16 * dt) = w; }
    __syncthreads();
}

struct RetRegs { u32x4 v[4], k[4], s[4]; };
__device__ __forceinline__ void ret_issue(RetRegs& R, int b, int n, int h, int tid) {
    const int t0 = n == 0 ? 0 : NMETA + 128 * (n - 1), ntok = n == 0 ? NMETA : 128;
    const bf16_t* P = (const bf16_t*)(KA->ws + WS_PROJ) + (size_t)b * TT * DIN;
    const bf16_t* S = (const bf16_t*)KA->out + ((size_t)((b * NH + h) * 16 + (n >= 1 ? n - 1 : 0))) * 16384;
#pragma unroll
    for (int i = 0; i < 4; ++i) { const int idx = tid + NTHREADS * i, t = idx >> 4, cc = idx & 15;
        R.v[i] = (u32x4){0u, 0u, 0u, 0u}; R.k[i] = (u32x4){0u, 0u, 0u, 0u}; R.s[i] = (u32x4){0u, 0u, 0u, 0u};
        if (t < ntok) { const bf16_t* rp = P + (size_t)(t0 + t) * DIN + 128 * h + 8 * cc; R.v[i] = *(const u32x4*)(rp + C_V); R.k[i] = *(const u32x4*)(rp + C_K); }
        if (n >= 1) R.s[i] = *(const u32x4*)(S + t * 128 + 8 * cc); }
}
__device__ __forceinline__ void ret_out_unit(LAS unsigned char* lds, int l, int b, int n, int h, RetRegs& R, bool has_next, int nb, int nn, int nh) {
    const bool nostore = false;
    const int tid = tidx(), lane = tid & 63, wave = __builtin_amdgcn_readfirstlane(tid >> 6), fr = lane & 15, fq = lane >> 4;
    const int t0 = n == 0 ? 0 : NMETA + 128 * (n - 1), ntok = n == 0 ? NMETA : 128;
    const float lg = lg2gamma(h);
    LAS bf16_t* vI = (LAS bf16_t*)lds; LAS bf16_t* SL = vI + 128 * RS; LAS bf16_t* kL = SL + 128 * SS;
    bf16_t* P = (bf16_t*)(KA->ws + WS_PROJ) + (size_t)b * TT * DIN;
#pragma unroll
    for (int i = 0; i < 4; ++i) { const int idx = tid + NTHREADS * i, t = idx >> 4, cc = idx & 15;
        *(LAS u32x4*)(vI + t * RS + 8 * cc) = R.v[i]; *(LAS u32x4*)(kL + t * SS + 8 * cc) = R.k[i];
        if (n >= 1) *(LAS u32x4*)(SL + t * SS + 8 * cc) = R.s[i]; }
    __syncthreads();
    if (has_next) ret_issue(R, nb, nn, nh, tid);
    if (16 * wave < ntok) {
        const int c = 16 * wave + fr;
        bf16_t* qrow = P + (size_t)(t0 + c) * DIN + 128 * h;
        bf16x8 qf[4];
#pragma unroll
        for (int kd = 0; kd < 4; ++kd) qf[kd] = *(const bf16x8*)(qrow + C_Q + 32 * kd + 8 * fq);
        f32x4 y[8];
#pragma unroll
        for (int et = 0; et < 8; ++et) y[et] = (f32x4){0.f, 0.f, 0.f, 0.f};
        if (n >= 1) {
            const float xi = exp2f((float)(c + 1) * lg);
#pragma unroll
            for (int et = 0; et < 8; ++et) {
#pragma unroll
                for (int kd = 0; kd < 4; ++kd) y[et] = mfma16(*(const LAS bf16x8*)(SL + (16 * et + fr) * SS + 32 * kd + 8 * fq), qf[kd], y[et]);
                y[et] = y[et] * xi;
            }
        }
        for (int p = 0; p <= (wave >> 1); ++p) {
            f32x4 sc0 = {0.f, 0.f, 0.f, 0.f}, sc1 = {0.f, 0.f, 0.f, 0.f};
            { const LAS bf16_t* kr = kL + (32 * p + fr) * SS + 8 * fq;
#pragma unroll
              for (int kd = 0; kd < 4; ++kd) sc0 = mfma16(*(const LAS bf16x8*)(kr + 32 * kd), qf[kd], sc0); }
            if (2 * p + 1 <= wave) { const LAS bf16_t* kr = kL + (32 * p + 16 + fr) * SS + 8 * fq;
#pragma unroll
              for (int kd = 0; kd < 4; ++kd) sc1 = mfma16(*(const LAS bf16x8*)(kr + 32 * kd), qf[kd], sc1); }
            float pv[8];
#pragma unroll
            for (int j = 0; j < 4; ++j) { const int s0 = 32 * p + 4 * fq + j, s1 = s0 + 16;
                pv[j] = (c >= s0) ? sc0[j] * __builtin_amdgcn_exp2f((float)(c - s0) * lg) : 0.f; pv[4 + j] = (c >= s1) ? sc1[j] * __builtin_amdgcn_exp2f((float)(c - s1) * lg) : 0.f; }
            u32x4 w; w.x = pk2(pv[0], pv[1]); w.y = pk2(pv[2], pv[3]); w.z = pk2(pv[4], pv[5]); w.w = pk2(pv[6], pv[7]);
            const bf16x8 pf = __builtin_bit_cast(bf16x8, w);
#pragma unroll
            for (int et = 0; et < 8; ++et) y[et] = mfma16(ld_tr(vI, 32 * p + 4 * fq, 32 * p + 16 + 4 * fq, 16 * et, fr), pf, y[et]);
        }
        float s1 = 0.f;
#pragma unroll
        for (int et = 0; et < 8; ++et) s1 += (y[et][0] + y[et][1]) + (y[et][2] + y[et][3]);
        s1 += __shfl_xor(s1, 16); s1 += __shfl_xor(s1, 32);
        const float mu = s1 * (1.0f / 128.0f);
        float s2 = 0.f;
#pragma unroll
        for (int et = 0; et < 8; ++et) { y[et] = y[et] - mu; s2 += (y[et][0] * y[et][0] + y[et][1] * y[et][1]) + (y[et][2] * y[et][2] + y[et][3] * y[et][3]); }
        s2 += __shfl_xor(s2, 16); s2 += __shfl_xor(s2, 32);
        const float rs = rsqrtf(s2 * (1.0f / 128.0f) + EPS);
        const float* gn = KA->in[I_RETN] + l * 512 + 128 * h + 4 * fq;
#pragma unroll
        for (int et = 0; et < 8; ++et) {
            const u32x2 gw = *(const u32x2*)(qrow + C_GR + 16 * et + 4 * fq); const f32x4 gv = *(const f32x4*)(gn + 16 * et);
            const float g0 = __uint_as_float(gw.x << 16), g1 = __uint_as_float(gw.x & 0xffff0000u), g2 = __uint_as_float(gw.y << 16), g3 = __uint_as_float(gw.y & 0xffff0000u);
            u32x2 o; o.x = pk2(y[et][0] * rs * gv[0] * g0 * sigmoidf_(g0), y[et][1] * rs * gv[1] * g1 * sigmoidf_(g1)); o.y = pk2(y[et][2] * rs * gv[2] * g2 * sigmoidf_(g2), y[et][3] * rs * gv[3] * g3 * sigmoidf_(g3));
            if (!nostore) *(u32x2*)(qrow + C_V + 16 * et + 4 * fq) = o;
        }
    }
    __syncthreads();
}

__device__ __forceinline__ void prefix_phase(int G, bool nostore = false) {
    const int gt = bidx() * NTHREADS + tidx(), NGT = G * NTHREADS;
    bf16_t* SB = (bf16_t*)KA->out;
    for (int i = gt; i < NB * NH * 4096; i += NGT) {
        const int bh = i >> 12, ed = (i & 4095) * 4, h = bh & 3;
        const float g128 = exp2f(128.0f * lg2gamma(h));
        u32x2* base = (u32x2*)(SB + (size_t)bh * 16 * 16384 + ed);
        u32x2 v[16];
#pragma unroll
        for (int n = 0; n < 16; ++n) v[n] = base[(size_t)n * 4096];
        f32x4 run = {__uint_as_float(v[0].x << 16), __uint_as_float(v[0].x & 0xffff0000u), __uint_as_float(v[0].y << 16), __uint_as_float(v[0].y & 0xffff0000u)};
#pragma unroll
        for (int n = 1; n < 16; ++n) {
            const f32x4 kv = {__uint_as_float(v[n].x << 16), __uint_as_float(v[n].x & 0xffff0000u), __uint_as_float(v[n].y << 16), __uint_as_float(v[n].y & 0xffff0000u)};
            run = run * g128 + kv;
            u32x2 w; w.x = pk2(run[0], run[1]); w.y = pk2(run[2], run[3]);
            if (!nostore) base[(size_t)n * 4096] = w;
        }
    }
    const float* sh = (const float*)(KA->ws + WS_SUMH); const float* sl = (const float*)(KA->ws + WS_SUML); float* cr = (float*)(KA->ws + WS_CARRY);
    for (int i = gt; i < NB * DLRU; i += NGT) {
        const int b = i >> 9, ch = i & 511; const size_t i0 = (size_t)b * NLC * DLRU + ch;
        float hh[NLC], ll[NLC];
#pragma unroll
        for (int c = 0; c < NLC; ++c) { hh[c] = sh[i0 + (size_t)c * DLRU]; ll[c] = sl[i0 + (size_t)c * DLRU]; }
        float h = 0.f;
#pragma unroll
        for (int c = 0; c < NLC; ++c) { if (!nostore) cr[i0 + (size_t)c * DLRU] = h; h = hh[c] + __builtin_amdgcn_exp2f(ll[c]) * h; }
    }
}

constexpr int N_PHASES = 2 + 7 * DEPTH;

__global__ void __launch_bounds__(NTHREADS, 2) hymba_fwd(Args a) {
    extern __shared__ __attribute__((aligned(16))) unsigned char lds_raw[];
    LAS unsigned char* lds = (LAS unsigned char*)lds_raw;
    const int G = gridDim.x;
#if MK_PER_PHASE
    const int lo = KA->ph_lo, hi = KA->ph_hi;
#define IN(k) (lo <= (k) && (k) < hi)
#define SEAM(k) do { } while (0)
#else
#define IN(k) true
#define SEAM(k) do { XcdBarrier b_; b_.bar = (unsigned*)(KA->ws); b_.x = xb_xcc_id(); b_.st = (volatile LAS unsigned*)(lds + LDS_BYTES - 64); xcd_barrier(b_); } while (0)
#endif
#define P_HB ((bf16_t*)(KA->ws + WS_HB))
#define P_PROJ ((bf16_t*)(KA->ws + WS_PROJ))
#define P_SSQ ((float*)(KA->ws + WS_SSQ))
#define P_HM ((float*)(KA->ws + WS_HM))
#define P_ROPE ((const f32x2*)(KA->ws + WS_ROPE))
#define P_W(l) ((const bf16_t*)(KA->ws + WS_W) + (size_t)(l) * W_LAYER_E)
    int ph = 0;
#if !MK_PER_PHASE
    if (threadIdx.x < 16) ((LAS unsigned*)(lds + LDS_BYTES - 64))[threadIdx.x] = 0u;
    __syncthreads();
    (void)xcd_barrier_post((unsigned*)(KA->ws), (volatile LAS unsigned*)(lds + LDS_BYTES - 64));
#endif

    if (IN(ph)) prologue(lds, G);
#ifdef PROBE_DUP_PRO
    prologue(lds, G);
#endif
#if !MK_PER_PHASE
    SEAM(ph);
    if (KA->ph_hi == 0x7fffffff) cg::this_grid().sync();
#endif
    ++ph;

    for (int l = 0; l < DEPTH; ++l) {
        if (IN(ph)) {
            { pg8::Gemm g{P_HB, P_W(l), DM, DIN, DM}; pg8::StaticOrder S; S.init(MROWS, DIN, G, bidx(), 2);
              pg8::fill_rstd_tables(lds, P_SSQ, S);
              pg8::EpiProj E{P_PROJ, (const LAS float*)(lds + pg8::RSTD_OFF), P_ROPE};
              pg8::gemm_phase<pg8::EpiProj, true, true>(lds, g, S, E);
#ifdef PROBE_DUP_G1
              pg8::gemm_phase<pg8::EpiProj, true, true>(lds, g, S, E);
#endif
            }
            if (bidx() < DIN / 16) skinny_item<0, DM>(lds, bidx(), P_HM, nullptr, 0, P_W(l), nullptr, P_PROJ, P_ROPE);
        }
        SEAM(ph); ++ph;
        if (IN(ph)) {
            constexpr int NL = NB * NLC, NR = NB * 16 * NH;
            const bool ldsc = G >= 256;
            int u = bidx() + 256;
            for (; u < NL; u += G) lru_unit(lds, l, u - 256, 0, false);
            if (u < NL + NR) {
                KvRegs R; int r = u - NL, kb, kn, kh;
                if (r < 480) { kb = r / 60; kn = 1 + ((r % 60) >> 2); kh = r & 3; } else { kb = (r - 480) >> 2; kn = 0; kh = r & 3; }
                kv_issue(R, kb, kn, kh, tidx());
                for (;;) {
                    const int rn = r + G; const bool hn = rn < NR; int nb2 = 0, nn2 = 0, nh2 = 0;
                    if (hn) { if (rn < 480) { nb2 = rn / 60; nn2 = 1 + ((rn % 60) >> 2); nh2 = rn & 3; } else { nb2 = (rn - 480) >> 2; nn2 = 0; nh2 = rn & 3; } }
                    ret_kv_unit(lds, kb, kn, kh, R, hn, nb2, nn2, nh2);
                    if (!hn) break;
                    r = rn; kb = nb2; kn = nn2; kh = nh2;
                }
            }
            for (int u = bidx(); u < 256; u += G) lru_unit(lds, l, u >> 5, 1 + (u & 31), false, false, ldsc);
        }
#ifdef PROBE_DUP_SYNC
        SEAM(ph); SEAM(ph); SEAM(ph); SEAM(ph); SEAM(ph); SEAM(ph); SEAM(ph);
#endif
        SEAM(ph); ++ph;
#ifdef PROBE_DRY_M15
        prefix_phase(G, KA->ph_lo == 0);
#endif
        if (IN(ph)) prefix_phase(G);
        SEAM(ph); ++ph;
        if (IN(ph)) {
            constexpr int NL = NB * NLC, NR = NB * NRC * NH;
            const bool ldsc = G >= 256;
            for (int u = bidx(); u < 256; u += G) lru_unit(lds, l, u >> 5, 1 + (u & 31), true, false, ldsc);
            int u = bidx() + 256;
            for (; u < NL; u += G) lru_unit(lds, l, u - 256, 0, true);
            if (u < NL + NR) {
                RetRegs R; int r = u - NL, rb, rn_, rh;
                if (r < 512) { rb = r >> 6; rn_ = 1 + ((r >> 2) & 15); rh = r & 3; } else { rb = (r - 512) >> 2; rn_ = 0; rh = r & 3; }
                ret_issue(R, rb, rn_, rh, tidx());
                for (;;) {
                    const int r2 = r + G; const bool hn = r2 < NR; int nb2 = 0, nn2 = 0, nh2 = 0;
                    if (hn) { if (r2 < 512) { nb2 = r2 >> 6; nn2 = 1 + ((r2 >> 2) & 15); nh2 = r2 & 3; } else { nb2 = (r2 - 512) >> 2; nn2 = 0; nh2 = r2 & 3; } }
                    ret_out_unit(lds, l, rb, rn_, rh, R, hn, nb2, nn2, nh2);
                    if (!hn) break;
                    r = r2; rb = nb2; rn_ = nn2; rh = nh2;
                }
            }
        }
        SEAM(ph); ++ph;
        if (IN(ph)) {
            { pg8::Gemm g{P_PROJ + C_GL, P_W(l) + W_IN_E, DIN, DM, DM}; pg8::StaticOrder S; S.init(MROWS, DM, G, bidx());
#ifdef PROBE_DRY_G24
              { pg8::EpiDry Ed{P_SSQ}; pg8::gemm_phase<pg8::EpiDry, false, true>(lds, g, S, Ed); }
#endif

              pg8::EpiRes E{P_HB, P_SSQ};
              pg8::gemm_phase<pg8::EpiRes, false, true>(lds, g, S, E); }
            if (bidx() < DM / 16) skinny_item<1, DM>(lds, bidx(), nullptr, P_PROJ + C_GL, DIN, P_W(l) + W_IN_E, P_HM, nullptr, nullptr);
        }
        SEAM(ph); ++ph;
        if (IN(ph)) {
            { pg8::Gemm g{P_HB, P_W(l) + W_IN_E + W_OUT_E, DM, 2 * DFF, DM}; pg8::StaticOrder S; S.init(MROWS, 2 * DFF, G, bidx());
              pg8::fill_rstd_tables(lds, P_SSQ, S);
              pg8::EpiGlu E{P_PROJ, (const LAS float*)(lds + pg8::RSTD_OFF)};
              pg8::gemm_phase<pg8::EpiGlu, true, true>(lds, g, S, E);
#ifdef PROBE_DUP_G3
              pg8::gemm_phase<pg8::EpiGlu, true, true>(lds, g, S, E);
#endif
            }
            for (int i = bidx() - G / 2; i >= 0 && i < DFF / 16; i += G / 2) skinny_item<2, DM>(lds, i, P_HM, nullptr, 0, P_W(l) + W_IN_E + W_OUT_E, nullptr, P_PROJ, nullptr);
        }
        SEAM(ph); ++ph;
        if (IN(ph)) {
            { pg8::Gemm g{P_PROJ, P_W(l) + W_IN_E + W_OUT_E + W_GU_E, DFF, DM, DFF}; pg8::StaticOrder S; S.init(MROWS, DM, G, bidx());
#ifdef PROBE_DRY_G24
              { pg8::EpiDry Ed{P_SSQ}; pg8::gemm_phase<pg8::EpiDry, false, true>(lds, g, S, Ed); }
#endif

              pg8::EpiRes E{P_HB, P_SSQ};
              pg8::gemm_phase<pg8::EpiRes, false, true>(lds, g, S, E); }
            if (bidx() < DM / 16) skinny_item<1, DFF>(lds, bidx(), nullptr, P_PROJ, DFF, P_W(l) + W_IN_E + W_OUT_E + W_GU_E, P_HM, nullptr, nullptr);
        }
        SEAM(ph); ++ph;
    }
    if (IN(ph)) {
        const int tid = tidx(), lane = tid & 63, gw = bidx() * 8 + (tid >> 6), NGW = G * 8;
        const float* gnp = KA->in[I_NFIN] + 8 * lane; const f32x4 g0 = *(const f32x4*)gnp, g1 = *(const f32x4*)(gnp + 4), g2 = *(const f32x4*)(gnp + 512), g3 = *(const f32x4*)(gnp + 516);
        const float* ssq = P_SSQ; float* outp = KA->out; const bf16_t* hbp = P_HB;
        for (int m0 = gw; m0 < MROWS; m0 += 4 * NGW) {
            f32x4 sq[4][4]; u32x4 ha[4], hb2[4];
#pragma unroll
            for (int q = 0; q < 4; ++q) { const int m = m0 + q * NGW; if (m < MROWS) {
                const f32x4* sp = (const f32x4*)(ssq + (size_t)m * 16); sq[q][0] = sp[0]; sq[q][1] = sp[1]; sq[q][2] = sp[2]; sq[q][3] = sp[3];
                const u32x4* hr = (const u32x4*)(hbp + (size_t)rowX(m) * DM) + lane; ha[q] = hr[0]; hb2[q] = hr[64]; } }
#pragma unroll
            for (int q = 0; q < 4; ++q) { const int m = m0 + q * NGW; if (m < MROWS) {
                const f32x4 t = (sq[q][0] + sq[q][1]) + (sq[q][2] + sq[q][3]);
                const float rs = rsqrtf(((t[0] + t[1]) + (t[2] + t[3])) * (1.0f / DM) + EPS);
                const u32x4 a = ha[q], b = hb2[q];
                f32x4* xr = (f32x4*)(outp + (size_t)m * DM) + 2 * lane;
                xr[0] = (f32x4){__uint_as_float(a.x << 16), __uint_as_float(a.x & 0xffff0000u), __uint_as_float(a.y << 16), __uint_as_float(a.y & 0xffff0000u)} * rs * g0;
                xr[1] = (f32x4){__uint_as_float(a.z << 16), __uint_as_float(a.z & 0xffff0000u), __uint_as_float(a.w << 16), __uint_as_float(a.w & 0xffff0000u)} * rs * g1;
                xr[128] = (f32x4){__uint_as_float(b.x << 16), __uint_as_float(b.x & 0xffff0000u), __uint_as_float(b.y << 16), __uint_as_float(b.y & 0xffff0000u)} * rs * g2;
                xr[129] = (f32x4){__uint_as_float(b.z << 16), __uint_as_float(b.z & 0xffff0000u), __uint_as_float(b.w << 16), __uint_as_float(b.w & 0xffff0000u)} * rs * g3; } }
        }
    }
#undef IN
#undef SEAM
}

#ifndef MK_PER_PHASE
#define MK_PER_PHASE 0
#endif
extern "C" void kernel_launch(void* const* d_in, const int* in_sizes, int n_in, void* d_out, int out_size, void* d_ws, size_t ws_size, hipStream_t stream) {
    static int grid = 0;
    if (grid == 0) {
        if (n_in != 19 || out_size != MROWS * DM || ws_size < WS_END) { fprintf(stderr, "kernel_launch: unexpected shapes (n_in %d out %d ws %zu)\n", n_in, out_size, ws_size); grid = -1; return; }
        int dev = 0, cus = 0, per_cu = 0;
        hipGetDevice(&dev); hipDeviceGetAttribute(&cus, hipDeviceAttributeMultiprocessorCount, dev);
        if (hipFuncSetAttribute((const void*)hymba_fwd, hipFuncAttributeMaxDynamicSharedMemorySize, LDS_BYTES) != hipSuccess) { fprintf(stderr, "kernel_launch: hipFuncSetAttribute failed\n"); grid = -1; return; }
        if (hipOccupancyMaxActiveBlocksPerMultiprocessor(&per_cu, (const void*)hymba_fwd, NTHREADS, LDS_BYTES) != hipSuccess || per_cu < 1) { fprintf(stderr, "kernel_launch: occupancy query says %d\n", per_cu); per_cu = 1; }
        (void)hipGetLastError();
        grid = cus * 1;
        if (grid <= 0) grid = 256;
    }
    if (grid < 0) return;
    if (hipMemsetAsync(d_ws, 0, 262144, stream) != hipSuccess) { fprintf(stderr, "kernel_launch: memset failed\n"); return; }
    Args a{};
    for (int i = 0; i < 19; ++i) a.in[i] = (const float*)d_in[i];
    a.out = (float*)d_out; a.ws = (unsigned char*)d_ws;
#if MK_PER_PHASE
    for (int p = 0; p < N_PHASES; ++p) { a.ph_lo = p; a.ph_hi = p + 1; hipLaunchKernelGGL(hymba_fwd, dim3(grid), dim3(NTHREADS), LDS_BYTES, stream, a); }
#else
    a.ph_lo = 0; a.ph_hi = N_PHASES;
    void* args[] = {&a};
    hipError_t e = hipLaunchCooperativeKernel((const void*)hymba_fwd, dim3(grid), dim3(NTHREADS), args, LDS_BYTES, stream);
    if (e != hipSuccess) fprintf(stderr, "cooperative launch failed: %s (grid %d)\n", hipGetErrorString(e), grid);
#endif
}
```

```cpp
#include <hip/hip_runtime.h>
#include <hip/hip_cooperative_groups.h>
#include <cstdio>
#include <cstdint>
namespace cg = cooperative_groups;

#define LAS __attribute__((address_space(3)))
typedef unsigned short bf16_t;
typedef short bf16x8 __attribute__((ext_vector_type(8)));
typedef float f32x4 __attribute__((ext_vector_type(4)));
typedef float f32x2 __attribute__((ext_vector_type(2)));
typedef unsigned u32x4 __attribute__((ext_vector_type(4)));
typedef unsigned u32x2 __attribute__((ext_vector_type(2)));

constexpr int NB = 8, SEQ = 2048, NMETA = 16, TT = SEQ + NMETA, DM = 1024, DIN = 3072, DFF = 2816, DEPTH = 4;
constexpr int MROWS = NB * SEQ;
constexpr int XROWS = NB * TT;
constexpr int DLRU = 512, HD = 128, NH = 4;
constexpr float EPS = 1e-6f;
constexpr int C_XL = 0, C_Q = 512, C_K = 1024, C_GL = 1536, C_V = 2048, C_GR = 2560;
constexpr int NLC = 33;
constexpr int NRC = 17;

__host__ __device__ __forceinline__ int rowX_tile(int pm) { return pm * 256 + 16 * (pm >> 3) + 16; }
__device__ __forceinline__ int rowX(int m) { return m + 16 * (m >> 11) + 16; }

constexpr size_t MiB = 1u << 20;
constexpr size_t WS_ROPE = 1 * MiB;
constexpr size_t WS_SSQ = 3 * MiB;
constexpr size_t WS_HM = 4 * MiB;
constexpr size_t WS_SUMH = 5 * MiB, WS_SUML = 6 * MiB, WS_CARRY = 7 * MiB;
constexpr size_t WS_WAX = 8 * MiB;
constexpr size_t WS_W = 10 * MiB;
constexpr size_t W_IN_E = (size_t)DIN * DM, W_OUT_E = (size_t)DM * DM, W_GU_E = (size_t)2 * DFF * DM, W_D_E = (size_t)DM * DFF;
constexpr size_t W_LAYER_E = W_IN_E + W_OUT_E + W_GU_E + W_D_E;
constexpr size_t WS_HB = 108 * MiB;
constexpr size_t WS_PROJ = 141 * MiB;
constexpr size_t WS_END = 238 * MiB;
constexpr size_t LC_BATCH = (size_t)NLC * 8 * 4 * 4 * 64 * 16;
constexpr size_t WS_LC1 = WS_HB + 16 * MiB;
constexpr size_t WS_LC2 = WS_END;
constexpr size_t WS_END2 = WS_LC2 + 5 * LC_BATCH;
static_assert(16 * MiB + 8 * LC_BATCH <= (size_t)MROWS * DM * 4, "retention state + LRU cache fit in d_out");
static_assert(WS_W + W_LAYER_E * 2 * DEPTH <= WS_HB && WS_HB + (size_t)XROWS * DM * 2 <= WS_PROJ && WS_PROJ + (size_t)XROWS * DIN * 2 <= WS_END, "ws map");

constexpr int LDS_BYTES = 147456;
constexpr int NTHREADS = 512;

__device__ __forceinline__ int tidx() { int t = threadIdx.x; asm volatile("" : "+v"(t)); return t; }
__device__ __forceinline__ int bidx() { int b = __builtin_amdgcn_readfirstlane((int)blockIdx.x); asm volatile("" : "+s"(b)); return b; }
__device__ __forceinline__ float bf2f(bf16_t u) { return __uint_as_float((unsigned)u << 16); }
__device__ __forceinline__ unsigned f2bf(float f) { unsigned u = __float_as_uint(f); return (u + 0x7fffu + ((u >> 16) & 1u)) >> 16; }
__device__ __forceinline__ unsigned pk2(float lo, float hi) { return f2bf(lo) | (f2bf(hi) << 16); }
__device__ __forceinline__ float wave_sum(float v) {
#pragma unroll
    for (int o = 1; o < 64; o <<= 1) v += __shfl_xor(v, o);
    return v;
}
__device__ __forceinline__ float frcp(float x) { return __builtin_amdgcn_rcpf(x); }
__device__ __forceinline__ float fexp(float x) { return __builtin_amdgcn_exp2f(x * 1.4426950408889634f); }
__device__ __forceinline__ float sigmoidf_(float x) { return frcp(1.0f + fexp(-x)); }
__device__ __forceinline__ float gelu_tanh(float x) { const float z = 0.7978845608028654f * (x + 0.044715f * x * x * x); const float t = 1.0f - 2.0f * frcp(1.0f + fexp(2.0f * z)); return 0.5f * x * (1.0f + t); }

__device__ const double INVF[64] = {1.0, 0.8659643233600653, 0.7498942093324559, 0.6493816315762113, 0.5623413251903491, 0.4869675251658631, 0.4216965034285822, 0.3651741272548377, 0.31622776601683794, 0.27384196342643613, 0.23713737056616552, 0.2053525026457146, 0.1778279410038923, 0.1539926526059492, 0.1333521432163324, 0.11547819846894582, 0.1, 0.08659643233600653, 0.07498942093324558, 0.06493816315762113, 0.05623413251903491, 0.04869675251658631, 0.042169650342858224, 0.03651741272548377, 0.03162277660168379, 0.027384196342643614, 0.023713737056616554, 0.02053525026457146, 0.01778279410038923, 0.01539926526059492, 0.01333521432163324, 0.011547819846894581, 0.01, 0.008659643233600654, 0.007498942093324558, 0.006493816315762113, 0.005623413251903491, 0.004869675251658631, 0.004216965034285823, 0.003651741272548377, 0.0031622776601683794, 0.0027384196342643613, 0.0023713737056616554, 0.002053525026457146, 0.0017782794100389228, 0.001539926526059492, 0.001333521432163324, 0.0011547819846894581, 0.001, 0.0008659643233600654, 0.0007498942093324559, 0.0006493816315762113, 0.0005623413251903491, 0.0004869675251658631, 0.00042169650342858224, 0.0003651741272548377, 0.00031622776601683794, 0.0002738419634264361, 0.00023713737056616554, 0.0002053525026457146, 0.00017782794100389227, 0.0001539926526059492, 0.0001333521432163324, 0.00011547819846894582};

namespace pg8 {
constexpr int BM = 256, BK = 64, HALF = 128, HTB = HALF * BK * 2, STAGE_BYTES = 8 * HTB, NXCD = 8, WGM = 4;
__device__ __forceinline__ int lds_byte(int r, int c) { const int st = (r >> 4) * 2 + (c >> 5), rr = r & 15, cc = c & 31, ob = rr * 64 + cc * 2; return st * 1024 + (ob ^ (((ob >> 9) & 1) << 5)); }
__device__ __forceinline__ void stage_rc(int b, int& R, int& C) { const int st = b / 1024, sb = b % 1024, swz = sb ^ (((sb >> 9) & 1) << 5); R = (st >> 1) * 16 + swz / 64; C = (st & 1) * 32 + (swz % 64) / 2; }
__device__ __forceinline__ int perm32(int rho) { const int n = rho >> 4, i = rho & 15; return 8 * (i >> 2) + 4 * n + (i & 3); }

struct Unit { int pm, pn, idx; };
struct Gemm { const bf16_t* A; const bf16_t* Bt; int lda, N, K; };

struct StaticOrder {
    int nM, nN, nwg, G, c, wgm;
    __device__ void init(int M, int N, int G_, int c_, int wgm_ = WGM) { nM = M / BM; nN = N / BM; nwg = nM * nN; G = G_; c = c_; wgm = wgm_; }
    __device__ bool next(int i, Unit& u) const {
        const long L = (long)i * G + c; if (L >= nwg) return false;
        int wgid = (int)L; { const int q = nwg / NXCD, r = nwg % NXCD, xcd = wgid % NXCD, off = wgid / NXCD; wgid = (xcd < r ? xcd * (q + 1) : r * (q + 1) + (xcd - r) * q) + off; }
        const int nig = wgm * nN, gid = wgid / nig, fm = gid * wgm, gsz = (nM - fm) < wgm ? (nM - fm) : wgm;
        u.pm = fm + ((wgid % nig) % gsz); u.pn = (wgid % nig) / gsz; return true;
    }
};

__device__ __forceinline__ unsigned cvt_pk_bf16(float lo, float hi) { unsigned r; asm volatile("v_cvt_pk_bf16_f32 %0, %1, %2" : "=v"(r) : "v"(lo), "v"(hi)); return r; }

__device__ __forceinline__ float row_rstd(const float* ssq, int rowm) {
    const f32x4* sp = (const f32x4*)(ssq + (size_t)rowm * 16);
    const f32x4 a = sp[0], b = sp[1], c = sp[2], d = sp[3];
    const float s = ((a[0] + a[1]) + (a[2] + a[3])) + ((b[0] + b[1]) + (b[2] + b[3])) + ((c[0] + c[1]) + (c[2] + c[3])) + ((d[0] + d[1]) + (d[2] + d[3]));
    return rsqrtf(s * (1.0f / DM) + EPS);
}

constexpr int RSTD_OFF = 131072, RSTD_MAX_UNITS = 8;
__device__ __forceinline__ void fill_rstd_tables(LAS unsigned char* lds, const float* ssq, const StaticOrder& S) {
    const int tid = tidx(), row = tid & 255; const bool odd = tid >= 256;
    LAS float* tab = (LAS float*)(lds + RSTD_OFF);
    f32x4 v[RSTD_MAX_UNITS / 2][4]; bool have[RSTD_MAX_UNITS / 2];
#pragma unroll
    for (int k = 0; k < RSTD_MAX_UNITS / 2; ++k) {
        Unit ua, ub; const bool ha = S.next(2 * k, ua), hb = S.next(2 * k + 1, ub);
        have[k] = odd ? hb : ha; const int pm = odd ? ub.pm : ua.pm;
        if (have[k]) { const f32x4* sp = (const f32x4*)(ssq + (size_t)(pm * BM + row) * 16); v[k][0] = sp[0]; v[k][1] = sp[1]; v[k][2] = sp[2]; v[k][3] = sp[3]; }
    }
#pragma unroll
    for (int k = 0; k < RSTD_MAX_UNITS / 2; ++k)
        if (have[k]) { const f32x4 t = (v[k][0] + v[k][1]) + (v[k][2] + v[k][3]);
            tab[(2 * k + (odd ? 1 : 0)) * 256 + row] = rsqrtf(((t[0] + t[1]) + (t[2] + t[3])) * (1.0f / DM) + EPS); }
    __syncthreads();
}
struct EpiProj {
    static constexpr bool PERM = true;
    bf16_t* P; const LAS float* rtab; const f32x2* rope;
    __device__ __forceinline__ void operator()(const f32x4 (&acc)[2][2][4][2], const Unit& u, int wr, int wc, int fr, int fq) const {
        const bool dorope = (u.pn >= 2 && u.pn < 6);
        const __amdgpu_buffer_rsrc_t rsrc = __builtin_amdgcn_make_buffer_rsrc(P, 0, XROWS * DIN * 2, 0x00020000);
#pragma unroll
        for (int ai = 0; ai < 2; ++ai)
#pragma unroll
            for (int m = 0; m < 4; ++m) {
                const int rl = ai * HALF + wr * 64 + m * 16 + fr, rowm = u.pm * BM + rl;
                const float rs = rtab[u.idx * 256 + rl];
                bf16_t* rowp = P + (size_t)(rowX_tile(u.pm) + rl) * DIN + u.pn * BM + wc * 32 + 8 * fq;
                f32x4 cs0 = {1.f, 0.f, 1.f, 0.f}, cs1 = {1.f, 0.f, 1.f, 0.f};
                if (dorope) { const f32x4* rp = (const f32x4*)(rope + (size_t)(NMETA + (rowm & (SEQ - 1))) * 64 + 16 * wc + 4 * fq); cs0 = rp[0]; cs1 = rp[1]; }
#pragma unroll
                for (int bj = 0; bj < 2; ++bj) {
                    f32x4 v0 = acc[ai][bj][m][0] * rs, v1 = acc[ai][bj][m][1] * rs;
                    if (dorope) {
                        const f32x4 a = v0, b = v1;
                        v0[0] = a[0] * cs0[0] - a[1] * cs0[1]; v0[1] = a[0] * cs0[1] + a[1] * cs0[0];
                        v0[2] = a[2] * cs0[2] - a[3] * cs0[3]; v0[3] = a[2] * cs0[3] + a[3] * cs0[2];
                        v1[0] = b[0] * cs1[0] - b[1] * cs1[1]; v1[1] = b[0] * cs1[1] + b[1] * cs1[0];
                        v1[2] = b[2] * cs1[2] - b[3] * cs1[3]; v1[3] = b[2] * cs1[3] + b[3] * cs1[2];
                    }
                    u32x4 w; w.x = cvt_pk_bf16(v0[0], v0[1]); w.y = cvt_pk_bf16(v0[2], v0[3]); w.z = cvt_pk_bf16(v1[0], v1[1]); w.w = cvt_pk_bf16(v1[2], v1[3]);
                    __builtin_amdgcn_raw_buffer_store_b128(w, rsrc, (int)((rowp + bj * HALF - P) * 2), 0, 16);
                }
            }
    }
};
struct EpiGlu {
    static constexpr bool PERM = true;
    bf16_t* O; const LAS float* rtab;
    __device__ __forceinline__ void operator()(const f32x4 (&acc)[2][2][4][2], const Unit& u, int wr, int wc, int fr, int fq) const {
        const __amdgpu_buffer_rsrc_t rsrc = __builtin_amdgcn_make_buffer_rsrc(O, 0, XROWS * DFF * 2, 0x00020000);
#pragma unroll
        for (int ai = 0; ai < 2; ++ai)
#pragma unroll
            for (int m = 0; m < 4; ++m) {
                const int rl = ai * HALF + wr * 64 + m * 16 + fr;
                const float rs = rtab[u.idx * 256 + rl];
                bf16_t* rowp = O + (size_t)(rowX_tile(u.pm) + rl) * DFF + u.pn * HALF + wc * 32 + 8 * fq;
                float o[8];
#pragma unroll
                for (int n = 0; n < 2; ++n)
#pragma unroll
                    for (int j = 0; j < 4; ++j) { const float g = acc[ai][0][m][n][j] * rs, up = acc[ai][1][m][n][j] * rs; o[n * 4 + j] = g * up * __builtin_amdgcn_rcpf(1.0f + __builtin_amdgcn_exp2f(g * -1.4426950408889634f)); }
                u32x4 w; w.x = cvt_pk_bf16(o[0], o[1]); w.y = cvt_pk_bf16(o[2], o[3]); w.z = cvt_pk_bf16(o[4], o[5]); w.w = cvt_pk_bf16(o[6], o[7]);
                __builtin_amdgcn_raw_buffer_store_b128(w, rsrc, (int)((rowp - O) * 2), 0, 16);
            }
    }
};
struct EpiRes {
    static constexpr bool PERM = false;
    bf16_t* hb; float* ssq;
    __device__ __forceinline__ void operator()(const f32x4 (&acc)[2][2][4][2], const Unit& u, int wr, int wc, int fr, int fq) const {
#pragma unroll
        for (int ai = 0; ai < 2; ++ai) {
            u32x2 pre[4][2][2];
#pragma unroll
            for (int m = 0; m < 4; ++m) { const size_t offx = (size_t)(rowX_tile(u.pm) + ai * HALF + wr * 64 + m * 16 + fr) * DM + u.pn * BM + wc * 32 + 4 * fq;
#pragma unroll
                for (int bj = 0; bj < 2; ++bj)
#pragma unroll
                    for (int n = 0; n < 2; ++n) pre[m][bj][n] = *(const u32x2*)(hb + offx + bj * HALF + n * 16); }
#pragma unroll
            for (int m = 0; m < 4; ++m) {
                const int rl = ai * HALF + wr * 64 + m * 16 + fr, rowm = u.pm * BM + rl;
                const size_t offx = (size_t)(rowX_tile(u.pm) + rl) * DM + u.pn * BM + wc * 32 + 4 * fq;
                float ss = 0.f;
#pragma unroll
                for (int bj = 0; bj < 2; ++bj)
#pragma unroll
                    for (int n = 0; n < 2; ++n) {
                        const u32x2 p = pre[m][bj][n];
                        const f32x4 v = (f32x4){__uint_as_float(p.x << 16), __uint_as_float(p.x & 0xffff0000u), __uint_as_float(p.y << 16), __uint_as_float(p.y & 0xffff0000u)} + acc[ai][bj][m][n];
                        u32x2 w; w.x = cvt_pk_bf16(v[0], v[1]); w.y = cvt_pk_bf16(v[2], v[3]);
                        *(u32x2*)(hb + offx + bj * HALF + n * 16) = w;
                        const float r0 = __uint_as_float(w.x << 16), r1 = __uint_as_float(w.x & 0xffff0000u), r2 = __uint_as_float(w.y << 16), r3 = __uint_as_float(w.y & 0xffff0000u);
                        ss += (r0 * r0 + r1 * r1) + (r2 * r2 + r3 * r3);
                    }
                ss += __shfl_xor(ss, 16); ss += __shfl_xor(ss, 32);
                if (fq == 0) ssq[(size_t)rowm * 16 + u.pn * 4 + wc] = ss;
            }
        }
    }
};
struct EpiDry {
    static constexpr bool PERM = false;
    float* sink;
    __device__ __forceinline__ void operator()(const f32x4 (&acc)[2][2][4][2], const Unit& u, int wr, int wc, int fr, int fq) const {
        f32x4 t = {0.f, 0.f, 0.f, 0.f};
#pragma unroll
        for (int ai = 0; ai < 2; ++ai)
#pragma unroll
            for (int bj = 0; bj < 2; ++bj)
#pragma unroll
                for (int m = 0; m < 4; ++m)
#pragma unroll
                    for (int n = 0; n < 2; ++n) t += acc[ai][bj][m][n];
        if (t[0] + t[1] + t[2] + t[3] == 1.2345e30f) sink[0] = t[0];
    }
};
template <class Epi, bool ALIGN_EPI, bool SP2>
__device__ __forceinline__ void gemm_phase(LAS unsigned char* lds, const Gemm g, const StaticOrder& S, const Epi& E) {
    const int tid = tidx(), wid = __builtin_amdgcn_readfirstlane(tid >> 6), lane = tid & 63, wr = wid >> 2, wc = wid & 3, fr = lane & 15, fq = lane >> 4;
    const int K = g.K, nt = K / BK, lda = g.lda;
    unsigned voffA[2], voffB[2];
#pragma unroll
    for (int i = 0; i < 2; ++i) { int R, C; stage_rc(tid * 16 + i * 8192, R, C); const int Rb = Epi::PERM ? ((R & ~31) + perm32(R & 31)) : R;
        voffA[i] = (unsigned)(R * lda + C) * 2u; voffB[i] = (unsigned)(Rb * K + C) * 2u; }
    const size_t kstep = (size_t)(BK * 2);
    const size_t hstepA = (size_t)HALF * lda * 2, hstepB = (size_t)HALF * K * 2;
    const size_t tstepB = 2 * hstepB;
    const unsigned ldsw = (unsigned)wid * 1024u;
    const int aoff = lds_byte(wr * 64 + fr, fq * 8), boff = lds_byte(wc * 32 + fr, fq * 8);
#define PG8_SA(b, h) (((b) * 2 + (h)) * HTB)
#define PG8_SB(b, h) ((4 + (b) * 2 + (h)) * HTB)
#define PG8_STAGE(bufoff, gbase, voff) do { _Pragma("unroll") for (int _i = 0; _i < 2; ++_i) \
        __builtin_amdgcn_global_load_lds((const unsigned*)((const char*)(gbase) + (voff)[_i]), (LAS unsigned*)(lds + (bufoff) + ldsw + _i * 8192), 16, 0, 0); } while (0)
#define PG8_LDA(dst, b, h) do { _Pragma("unroll") for (int m = 0; m < 4; ++m) _Pragma("unroll") for (int k = 0; k < 2; ++k) dst[m][k] = *(const LAS bf16x8*)(lds + PG8_SA(b, h) + aoff + m * 2048 + k * 1024); } while (0)
#define PG8_LDB(dst, b, h) do { _Pragma("unroll") for (int n = 0; n < 2; ++n) _Pragma("unroll") for (int k = 0; k < 2; ++k) dst[n][k] = *(const LAS bf16x8*)(lds + PG8_SB(b, h) + boff + n * 2048 + k * 1024); } while (0)
#define PG8_MMA(ai, bj, At, Bt) do { __builtin_amdgcn_s_setprio(1); _Pragma("unroll") for (int m = 0; m < 4; ++m) _Pragma("unroll") for (int n = 0; n < 2; ++n) _Pragma("unroll") for (int k = 0; k < 2; ++k) \
        acc[ai][bj][m][n] = __builtin_amdgcn_mfma_f32_16x16x32_bf16(Bt[n][k], At[m][k], acc[ai][bj][m][n], 0, 0, 0); __builtin_amdgcn_s_setprio(0); } while (0)
#define PG8_WAIT_V(n) asm volatile("s_waitcnt vmcnt(" #n ")" ::: "memory")
#define PG8_WAIT_L(n) asm volatile("s_waitcnt lgkmcnt(" #n ")" ::: "memory")
#define PG8_BAR __builtin_amdgcn_s_barrier()
#define PG8_SCHED __builtin_amdgcn_sched_barrier(0)
    Unit cur, nxt; int ui = 0;
    if (!S.next(0, cur)) return;
    cur.idx = 0;
    f32x4 acc[2][2][4][2];
#pragma unroll
    for (int a = 0; a < 2; ++a)
#pragma unroll
        for (int b = 0; b < 2; ++b)
#pragma unroll
            for (int m = 0; m < 4; ++m)
#pragma unroll
                for (int n = 0; n < 2; ++n) acc[a][b][m][n] = (f32x4){0.f, 0.f, 0.f, 0.f};
    bf16x8 At[4][2], B0[2][2], B1[2][2];
    const char* cA = (const char*)g.A + (size_t)rowX_tile(cur.pm) * lda * 2; const char* cB = (const char*)g.Bt + (size_t)cur.pn * tstepB;
    if constexpr (SP2) {
        PG8_STAGE(PG8_SB(0, 0), cB, voffB); PG8_STAGE(PG8_SB(0, 1), cB + hstepB, voffB); PG8_STAGE(PG8_SA(0, 0), cA, voffA); PG8_STAGE(PG8_SA(0, 1), cA + hstepA, voffA);
        if (wr == 1) PG8_BAR;
        PG8_WAIT_V(2); PG8_BAR;
        PG8_STAGE(PG8_SB(1, 0), cB + kstep, voffB); PG8_STAGE(PG8_SA(1, 0), cA + kstep, voffA); PG8_STAGE(PG8_SB(1, 1), cB + hstepB + kstep, voffB);
        PG8_WAIT_V(6); PG8_BAR;
    } else {
        PG8_STAGE(PG8_SB(0, 0), cB, voffB); PG8_STAGE(PG8_SA(0, 0), cA, voffA); PG8_STAGE(PG8_SB(0, 1), cB + hstepB, voffB); PG8_STAGE(PG8_SA(0, 1), cA + hstepA, voffA);
        if (wr == 1) PG8_BAR;
        PG8_WAIT_V(4); PG8_BAR;
        PG8_STAGE(PG8_SB(1, 0), cB + kstep, voffB); PG8_STAGE(PG8_SA(1, 0), cA + kstep, voffA); PG8_STAGE(PG8_SB(1, 1), cB + hstepB + kstep, voffB);
        PG8_WAIT_V(6); PG8_BAR;
    }
    for (;;) {
        const bool has_next = S.next(ui + 1, nxt); nxt.idx = ui + 1;
        const char* nA = has_next ? (const char*)g.A + (size_t)rowX_tile(nxt.pm) * lda * 2 : cA; const char* nB = has_next ? (const char*)g.Bt + (size_t)nxt.pn * tstepB : cB;
        for (int t = 0; t < nt; t += 2) {
            const bool last = (t == nt - 2);
            const char* a1 = cA + (size_t)(t + 1) * kstep;
            const char* a2 = last ? nA : cA + (size_t)(t + 2) * kstep; const char* b2 = last ? nB : cB + (size_t)(t + 2) * kstep;
            const char* a3 = a2 + kstep; const char* b3 = b2 + kstep;
            if constexpr (SP2) {
            PG8_LDB(B0, 0, 0); PG8_LDB(B1, 0, 1); PG8_SCHED; PG8_LDA(At, 0, 0); PG8_STAGE(PG8_SA(1, 1), a1 + hstepA, voffA);
            PG8_WAIT_V(8); PG8_WAIT_L(0); PG8_BAR; PG8_MMA(0, 0, At, B0); PG8_MMA(0, 1, At, B1); PG8_BAR; PG8_SCHED;
            PG8_LDA(At, 0, 1); PG8_STAGE(PG8_SB(0, 0), b2, voffB); PG8_STAGE(PG8_SB(0, 1), b2 + hstepB, voffB); PG8_STAGE(PG8_SA(0, 0), a2, voffA);
            PG8_WAIT_V(8); PG8_WAIT_L(0); PG8_BAR; PG8_MMA(1, 0, At, B0); PG8_MMA(1, 1, At, B1); PG8_BAR; PG8_SCHED;
            PG8_LDB(B0, 1, 0); PG8_LDB(B1, 1, 1); PG8_SCHED; PG8_LDA(At, 1, 0); PG8_STAGE(PG8_SA(0, 1), a2 + hstepA, voffA);
            PG8_WAIT_V(8); PG8_WAIT_L(0); PG8_BAR; PG8_MMA(0, 0, At, B0); PG8_MMA(0, 1, At, B1); PG8_BAR; PG8_SCHED;
            PG8_LDA(At, 1, 1); PG8_STAGE(PG8_SB(1, 0), b3, voffB); PG8_STAGE(PG8_SB(1, 1), b3 + hstepB, voffB); PG8_STAGE(PG8_SA(1, 0), a3, voffA);
            PG8_WAIT_V(8); PG8_WAIT_L(0); PG8_BAR; PG8_MMA(1, 0, At, B0); PG8_MMA(1, 1, At, B1); PG8_BAR; PG8_SCHED;
            } else {
            PG8_LDB(B0, 0, 0); PG8_SCHED; PG8_LDA(At, 0, 0); PG8_STAGE(PG8_SA(1, 1), a1 + hstepA, voffA);
            PG8_WAIT_L(8); PG8_BAR; PG8_WAIT_L(0); PG8_MMA(0, 0, At, B0); PG8_BAR; PG8_SCHED;
            PG8_LDB(B1, 0, 1); PG8_STAGE(PG8_SB(0, 0), b2, voffB);
            PG8_BAR; PG8_WAIT_L(0); PG8_MMA(0, 1, At, B1); PG8_BAR;
            PG8_LDA(At, 0, 1); PG8_STAGE(PG8_SA(0, 0), a2, voffA);
            PG8_BAR; PG8_WAIT_L(0); PG8_MMA(1, 0, At, B0); PG8_BAR; PG8_SCHED;
            PG8_STAGE(PG8_SB(0, 1), b2 + hstepB, voffB);
            PG8_WAIT_V(6); PG8_BAR; PG8_MMA(1, 1, At, B1); PG8_BAR;
            PG8_LDB(B0, 1, 0); PG8_SCHED; PG8_LDA(At, 1, 0); PG8_STAGE(PG8_SA(0, 1), a2 + hstepA, voffA);
            PG8_WAIT_L(8); PG8_BAR; PG8_WAIT_L(0); PG8_MMA(0, 0, At, B0); PG8_BAR; PG8_SCHED;
            PG8_LDB(B1, 1, 1); PG8_STAGE(PG8_SB(1, 0), b3, voffB);
            PG8_BAR; PG8_WAIT_L(0); PG8_MMA(0, 1, At, B1); PG8_BAR;
            PG8_LDA(At, 1, 1); PG8_STAGE(PG8_SA(1, 0), a3, voffA);
            PG8_BAR; PG8_WAIT_L(0); PG8_MMA(1, 0, At, B0); PG8_BAR; PG8_SCHED;
            PG8_STAGE(PG8_SB(1, 1), b3 + hstepB, voffB);
            PG8_WAIT_V(6); PG8_BAR; PG8_MMA(1, 1, At, B1); PG8_BAR;
            }
        }
        if constexpr (ALIGN_EPI) { if (wr == 0) PG8_BAR; }
        E(acc, cur, wr, wc, fr, fq);
        if (!has_next) break;
#pragma unroll
        for (int a = 0; a < 2; ++a)
#pragma unroll
            for (int b = 0; b < 2; ++b)
#pragma unroll
                for (int m = 0; m < 4; ++m)
#pragma unroll
                    for (int n = 0; n < 2; ++n) acc[a][b][m][n] = (f32x4){0.f, 0.f, 0.f, 0.f};
        cur = nxt; cA = nA; cB = nB; ++ui;
        if constexpr (ALIGN_EPI) { if (wr == 1) PG8_BAR; }
    }
    PG8_WAIT_V(0);
    if constexpr (!ALIGN_EPI) { if (wr == 0) PG8_BAR; }
    PG8_BAR;
#undef PG8_SA
#undef PG8_SB
#undef PG8_STAGE
#undef PG8_LDA
#undef PG8_LDB
#undef PG8_MMA
#undef PG8_WAIT_V
#undef PG8_WAIT_L
#undef PG8_BAR
#undef PG8_SCHED
}
}

#define XB_TMO      128
#define XB_XCNT(j)  (256  + 64 * (j))
#define XB_XSUB(j)  (1280 + 64 * (j))
#define XB_XGEN(j)  (2304 + 64 * (j))
#define XB_TOP      3328
#define XB_TOPGEN   3392
#define XCD_BAR_WORDS 3456
#define XB_SPIN_CAP (1u << 18)

__device__ __forceinline__ unsigned xb_ld(unsigned* p)              { return __hip_atomic_load(p, __ATOMIC_RELAXED, __HIP_MEMORY_SCOPE_AGENT); }
__device__ __forceinline__ unsigned xb_add(unsigned* p, unsigned v) { return __hip_atomic_fetch_add(p, v, __ATOMIC_RELAXED, __HIP_MEMORY_SCOPE_AGENT); }
__device__ __forceinline__ unsigned xb_xcc_id() { return (unsigned)__builtin_amdgcn_s_getreg((3 << 11) | 20) & 0xFu; }
#define XB_SPIN(cond, bar) do { unsigned _sp = 0; while (cond) { \
    if ((++_sp & 255u) == 0u) { if (xb_ld(&(bar)[XB_TMO])) break; if (_sp > XB_SPIN_CAP) { atomicAdd(&(bar)[XB_TMO], 1u); break; } } } } while (0)

struct XcdBarrier {
    unsigned* bar; unsigned x;
    volatile LAS unsigned* st;
};

__device__ __forceinline__ XcdBarrier xcd_barrier_post(unsigned* bar, volatile LAS unsigned* st) {
    XcdBarrier b; b.bar = bar; b.x = xb_xcc_id(); b.st = st;
    if (threadIdx.x == 0) (void)xb_add(&bar[XB_XCNT(b.x)], 1u);
    return b;
}
__device__ __forceinline__ void xcd_barrier_complete(unsigned* bar, unsigned x, unsigned& nloc, unsigned& nx) {
    const unsigned G = gridDim.x * gridDim.y * gridDim.z;
    unsigned sum, cnt, mine, sp = 0u;
    for (;;) {
        sum = 0u; cnt = 0u; mine = 0u;
#pragma unroll
        for (unsigned j = 0; j < 16; ++j) { const unsigned c = xb_ld(&bar[XB_XCNT(j)]); sum += c; cnt += (c > 0u) ? 1u : 0u; mine = (j == x) ? c : mine; }
        if (sum == G) break;
        __builtin_amdgcn_s_sleep(1);
        if ((++sp & 255u) == 0u) { if (xb_ld(&bar[XB_TMO])) break; if (sp > XB_SPIN_CAP) { atomicAdd(&bar[XB_TMO], 1u); break; } }
    }
    nloc = mine > 0u ? mine : 1u; nx = cnt > 0u ? cnt : 1u;
}

__device__ __forceinline__ void xcd_barrier(const XcdBarrier& b) {
    asm volatile("s_waitcnt vmcnt(0)" ::: "memory");
    __syncthreads();
    if (threadIdx.x == 0) {
        unsigned* bar = b.bar;
        __builtin_amdgcn_s_waitcnt(0);
        unsigned nloc = b.st[0], nx = b.st[1];
        if (nloc == 0u) { xcd_barrier_complete(bar, b.x, nloc, nx); b.st[0] = nloc; b.st[1] = nx; }
        const unsigned old = xb_add(&bar[XB_XSUB(b.x)], 1u);
        const unsigned gen = old / nloc;
        if (old + 1u == (gen + 1u) * nloc) {
            __builtin_amdgcn_fence(__ATOMIC_RELEASE, "agent");
            asm volatile("s_waitcnt vmcnt(0)" ::: "memory");
            const unsigned og = xb_add(&bar[XB_TOP], 1u);
            const unsigned tg = og / nx;
            if (og + 1u != (tg + 1u) * nx) XB_SPIN(xb_ld(&bar[XB_TOP]) < (tg + 1u) * nx, bar);
            __builtin_amdgcn_fence(__ATOMIC_ACQUIRE, "agent");
            xb_add(&bar[XB_XGEN(b.x)], 1u);
            asm volatile("s_waitcnt vmcnt(0)" ::: "memory");
        } else {
            XB_SPIN(xb_ld(&bar[XB_XGEN(b.x)]) == gen, bar);
            __builtin_amdgcn_fence(__ATOMIC_ACQUIRE, "agent");
            asm volatile("s_waitcnt vmcnt(0)" ::: "memory");
        }
    }
    __syncthreads();
}


struct Args { const float* in[19]; float* out; unsigned char* ws; int ph_lo, ph_hi; };
typedef const __attribute__((address_space(4))) Args* CArgsP;
__device__ __forceinline__ CArgsP kargs() { CArgsP p = (CArgsP)__builtin_amdgcn_kernarg_segment_ptr(); asm volatile("" : "+s"(p)); return p; }
#define KA (kargs())
enum { I_X = 0, I_META, I_NMIX, I_WIN, I_CONVW, I_CONVB, I_GAW, I_GAB, I_GXW, I_GXB, I_LAM, I_LRUN, I_RETN, I_WOUT, I_NFFN, I_WG, I_WU, I_WD, I_NFIN };

#define LDS_WAIT() asm volatile("s_waitcnt lgkmcnt(0)" ::: "memory")

struct TrDesc { const float* W; const float* gain; bf16_t* WT; int K, N, kind, k0, n0; };
__device__ __forceinline__ TrDesc tr_desc(int it) {
    constexpr int I_IN = (DM / 64) * (DIN / 32), I_OUT = (DM / 64) * (DM / 32), I_G = (DM / 64) * (DFF / 32);
    constexpr int PER_LAYER = I_IN + I_OUT + 2 * I_G + (DFF / 64) * (DM / 32);
    const int l = it / PER_LAYER; int r = it % PER_LAYER;
    bf16_t* wl = (bf16_t*)(KA->ws + WS_W) + (size_t)l * W_LAYER_E;
    TrDesc d;
    if (r < I_IN) { d.W = KA->in[I_WIN] + (size_t)l * DM * DIN; d.gain = KA->in[I_NMIX] + l * DM; d.WT = wl; d.K = DM; d.N = DIN; d.kind = 0; }
    else if ((r -= I_IN) < I_OUT) { d.W = KA->in[I_WOUT] + (size_t)l * DM * DM; d.gain = nullptr; d.WT = wl + W_IN_E; d.K = DM; d.N = DM; d.kind = 1; }
    else if ((r -= I_OUT) < I_G) { d.W = KA->in[I_WG] + (size_t)l * DM * DFF; d.gain = KA->in[I_NFFN] + l * DM; d.WT = wl + W_IN_E + W_OUT_E; d.K = DM; d.N = DFF; d.kind = 2; }
    else if ((r -= I_G) < I_G) { d.W = KA->in[I_WU] + (size_t)l * DM * DFF; d.gain = KA->in[I_NFFN] + l * DM; d.WT = wl + W_IN_E + W_OUT_E; d.K = DM; d.N = DFF; d.kind = 3; }
    else { r -= I_G; d.W = KA->in[I_WD] + (size_t)l * DFF * DM; d.gain = nullptr; d.WT = wl + W_IN_E + W_OUT_E + W_GU_E; d.K = DFF; d.N = DM; d.kind = 1; }
    const int nblk = d.N / 32; d.k0 = 64 * (r / nblk); d.n0 = 32 * (r % nblk);
    return d;
}
__device__ __forceinline__ void tr_load(const TrDesc& d, float (&v)[32], int lane) {
    const float* wp = d.W + (size_t)(d.k0 + (lane >> 5)) * d.N + d.n0 + (lane & 31);
#pragma unroll
    for (int i = 0; i < 32; ++i) v[i] = wp[(size_t)(2 * i) * d.N];
}
__device__ __forceinline__ void tr_emit(const TrDesc& d, const float (&v)[32], LAS float* scr, int lane) {
    const int c = lane & 7;
    f32x4 g0 = {1.f, 1.f, 1.f, 1.f}, g1 = {1.f, 1.f, 1.f, 1.f};
    if (d.gain) { g0 = *(const f32x4*)(d.gain + d.k0 + 8 * c); g1 = *(const f32x4*)(d.gain + d.k0 + 8 * c + 4); }
#pragma unroll
    for (int i = 0; i < 32; ++i) scr[(2 * i + (lane >> 5)) * 33 + (lane & 31)] = v[i];
    LDS_WAIT(); asm volatile("" ::: "memory");
#pragma unroll
    for (int j = 0; j < 4; ++j) {
        const int n = (lane >> 3) + 8 * j, ncol = d.n0 + n; int dest = ncol; float sc = 1.0f;
        if (d.kind == 0) { const int reg = ncol >> 9, r = ncol & 511, hh = r >> 7, dd = r & 127, p = 2 * (dd & 63) + (dd >> 6);
            if (reg == 0) dest = C_XL + r; else if (reg == 1) dest = C_GL + r; else if (reg == 2) dest = C_Q + 128 * hh + p;
            else if (reg == 3) { dest = C_K + 128 * hh + p; sc = 0.08838834764831845f; } else if (reg == 4) dest = C_V + r; else dest = C_GR + r; }
        else if (d.kind == 2) dest = (ncol >> 7) * 256 + (ncol & 127);
        else if (d.kind == 3) dest = (ncol >> 7) * 256 + 128 + (ncol & 127);
        const LAS float* s = scr + (8 * c) * 33 + n;
        u32x4 o; o.x = pk2(s[0 * 33] * (g0[0] * sc), s[1 * 33] * (g0[1] * sc)); o.y = pk2(s[2 * 33] * (g0[2] * sc), s[3 * 33] * (g0[3] * sc));
        o.z = pk2(s[4 * 33] * (g1[0] * sc), s[5 * 33] * (g1[1] * sc)); o.w = pk2(s[6 * 33] * (g1[2] * sc), s[7 * 33] * (g1[3] * sc));
        *(u32x4*)(d.WT + (size_t)dest * d.K + d.k0 + 8 * c) = o;
    }
    LDS_WAIT(); asm volatile("" ::: "memory");
}

__device__ __forceinline__ void prologue(LAS unsigned char* lds, int G) {
    const int tid = tidx(), lane = tid & 63, wave = __builtin_amdgcn_readfirstlane(tid >> 6);
    LAS float* scr = (LAS float*)(lds + wave * 16384);
    const int gw = bidx() * 8 + wave, NGW = G * 8;
    {
        constexpr int TOTAL = ((DM / 64) * (DIN / 32) + (DM / 64) * (DM / 32) + 2 * (DM / 64) * (DFF / 32) + (DFF / 64) * (DM / 32)) * DEPTH;
        float va[32], vb[32]; TrDesc da, db;
        int it = gw;
        if (it < TOTAL) { da = tr_desc(it); tr_load(da, va, lane); }
        while (it < TOTAL) {
            int nx = it + NGW;
            if (nx < TOTAL) { db = tr_desc(nx); tr_load(db, vb, lane); }
            tr_emit(da, va, scr, lane);
            it = nx; nx = it + NGW;
            if (it < TOTAL) { if (nx < TOTAL) { da = tr_desc(nx); tr_load(da, va, lane); } tr_emit(db, vb, scr, lane); it = nx; }
        }
    }
    const float* x = KA->in[I_X]; bf16_t* HB = (bf16_t*)(KA->ws + WS_HB); float* ssq = (float*)(KA->ws + WS_SSQ);
    for (int m0 = gw; m0 < MROWS; m0 += 2 * NGW) {
        f32x4 v[2][4];
#pragma unroll
        for (int q = 0; q < 2; ++q) { const int m = m0 + q * NGW; if (m < MROWS) { const f32x4* xr = (const f32x4*)(x + (size_t)m * DM) + lane;
#pragma unroll
            for (int j = 0; j < 4; ++j) v[q][j] = xr[64 * j]; } }
#pragma unroll
        for (int q = 0; q < 2; ++q) { const int m = m0 + q * NGW; if (m < MROWS) {
            float s = 0.f;
#pragma unroll
            for (int j = 0; j < 4; ++j) s += (v[q][j][0] * v[q][j][0] + v[q][j][1] * v[q][j][1]) + (v[q][j][2] * v[q][j][2] + v[q][j][3] * v[q][j][3]);
            s = wave_sum(s);
            u32x2* o = (u32x2*)(HB + (size_t)rowX(m) * DM) + lane;
#pragma unroll
            for (int j = 0; j < 4; ++j) { u32x2 w; w.x = pk2(v[q][j][0], v[q][j][1]); w.y = pk2(v[q][j][2], v[q][j][3]); o[64 * j] = w; }
            if (lane < 16) ssq[(size_t)m * 16 + lane] = (lane == 0) ? s : 0.f; } }
    }
    const int gt = bidx() * NTHREADS + tid, NGT = G * NTHREADS;
    f32x2* rope = (f32x2*)(KA->ws + WS_ROPE);
    for (int i = gt; i < TT * 64; i += NGT) {
        const int pos = i >> 6, f = i & 63;
        const double rev = (double)pos * INVF[f] * 0.15915494309189535;
        const float fr = (float)(rev - floor(rev));
        rope[i] = (f32x2){__builtin_amdgcn_cosf(fr), __builtin_amdgcn_sinf(fr)};
    }
    { bf16_t* wax = (bf16_t*)(KA->ws + WS_WAX);
      for (int i = gt; i < DEPTH * 8 * 2 * 64 * 64; i += NGT) { const int ii = i & 63, j = (i >> 6) & 63, which = (i >> 12) & 1, lg8 = i >> 13;
          const float* src = which ? KA->in[I_GXW] : KA->in[I_GAW]; wax[i] = (bf16_t)f2bf(-1.4426950408889634f * src[((size_t)lg8 * 64 + ii) * 64 + j]); } }
    float* HM = (float*)(KA->ws + WS_HM);
    for (int i = gt; i < NMETA * DM; i += NGT) HM[i] = KA->in[I_META][i];
}

template <int MODE, int K>
__device__ __forceinline__ void skinny_item(LAS unsigned char* lds, int item, const float* HMr, const bf16_t* Abf, int lda, const bf16_t* Bt, float* HMw, bf16_t* Obf, const f32x2* rope) {
    const int tid = tidx(), lane = tid & 63, wave = __builtin_amdgcn_readfirstlane(tid >> 6), fr = lane & 15, fq = lane >> 4;
    const int n0 = item * 16;
    int brow = n0 + fr; if (MODE == 2) brow = (n0 >> 7) * 256 + (n0 & 127) + fr;
    constexpr int kper = K / 8, KSTEPS = kper / 32; const int kbeg = wave * kper;
    f32x4 acc = {0.f, 0.f, 0.f, 0.f}, acc2 = {0.f, 0.f, 0.f, 0.f}; float ss = 0.f;
    const int colE = n0 + 4 * fq;
    f32x4 hmv = {0.f, 0.f, 0.f, 0.f}; f32x2 rc0 = {1.f, 0.f}, rc1 = {1.f, 0.f};
    if (MODE == 1) hmv = *(const f32x4*)(HMw + (size_t)fr * DM + colE);
    if (MODE == 0 && colE >= C_Q && colE < C_GL) { const int i0 = (colE & 127) >> 1; rc0 = rope[fr * 64 + i0]; rc1 = rope[fr * 64 + i0 + 1]; }
    bf16x8 bq[KSTEPS], bq2[KSTEPS], aq[KSTEPS]; f32x4 au[KSTEPS], av[KSTEPS];
#pragma unroll
    for (int st = 0; st < KSTEPS; ++st) { const int k0 = kbeg + 32 * st;
        if (MODE == 1) aq[st] = *(const bf16x8*)(Abf + (size_t)fr * lda + k0 + 8 * fq);
        else { const f32x4* p = (const f32x4*)(HMr + (size_t)fr * DM + k0 + 8 * fq); au[st] = p[0]; av[st] = p[1]; }
        bq[st] = *(const bf16x8*)(Bt + (size_t)brow * K + k0 + 8 * fq);
        if (MODE == 2) bq2[st] = *(const bf16x8*)(Bt + (size_t)(brow + 128) * K + k0 + 8 * fq); }
    __builtin_amdgcn_sched_barrier(0);
#pragma unroll
    for (int st = 0; st < KSTEPS; ++st) {
        bf16x8 af;
        if (MODE == 1) af = aq[st];
        else { const f32x4 u = au[st], v = av[st];
            ss += (u[0] * u[0] + u[1] * u[1]) + (u[2] * u[2] + u[3] * u[3]) + (v[0] * v[0] + v[1] * v[1]) + (v[2] * v[2] + v[3] * v[3]);
            u32x4 w; w.x = pk2(u[0], u[1]); w.y = pk2(u[2], u[3]); w.z = pk2(v[0], v[1]); w.w = pk2(v[2], v[3]); af = __builtin_bit_cast(bf16x8, w); }
        acc = __builtin_amdgcn_mfma_f32_16x16x32_bf16(bq[st], af, acc, 0, 0, 0);
        if (MODE == 2) acc2 = __builtin_amdgcn_mfma_f32_16x16x32_bf16(bq2[st], af, acc2, 0, 0, 0);
    }
    ss += __shfl_xor(ss, 16); ss += __shfl_xor(ss, 32);
    LAS float* red = (LAS float*)lds;
    LAS float* mine = red + (wave * 64 + lane) * 9;
    mine[0] = acc[0]; mine[1] = acc[1]; mine[2] = acc[2]; mine[3] = acc[3]; mine[4] = acc2[0]; mine[5] = acc2[1]; mine[6] = acc2[2]; mine[7] = acc2[3]; mine[8] = ss;
    __syncthreads();
    if (wave == 0) {
        float r[9];
#pragma unroll
        for (int q = 0; q < 9; ++q) { float s = 0.f;
#pragma unroll
            for (int w = 0; w < 8; ++w) s += red[(w * 64 + lane) * 9 + q]; r[q] = s; }
        const float rs = rsqrtf(r[8] * (1.0f / DM) + EPS);
        const int col = n0 + 4 * fq;
        if (MODE == 0) {
            float v0 = r[0] * rs, v1 = r[1] * rs, v2 = r[2] * rs, v3 = r[3] * rs;
            if (col >= C_Q && col < C_GL) { const f32x2 c0 = rc0, c1 = rc1;
                const float a0 = v0, a1 = v1, a2 = v2, a3 = v3; v0 = a0 * c0[0] - a1 * c0[1]; v1 = a0 * c0[1] + a1 * c0[0]; v2 = a2 * c1[0] - a3 * c1[1]; v3 = a2 * c1[1] + a3 * c1[0]; }
            u32x2 w; w.x = pk2(v0, v1); w.y = pk2(v2, v3);
#pragma unroll
            for (int b = 0; b < NB; ++b) *(u32x2*)(Obf + (size_t)(b * TT + fr) * DIN + col) = w;
        } else if (MODE == 1) {
            f32x4* p = (f32x4*)(HMw + (size_t)fr * DM + col); f32x4 v = hmv; v[0] += r[0]; v[1] += r[1]; v[2] += r[2]; v[3] += r[3]; *p = v;
        } else {
            float o[4];
#pragma unroll
            for (int j = 0; j < 4; ++j) { const float g = r[j] * rs, up = r[4 + j] * rs; o[j] = g * up * __builtin_amdgcn_rcpf(1.0f + __builtin_amdgcn_exp2f(g * -1.4426950408889634f)); }
            u32x2 w; w.x = pk2(o[0], o[1]); w.y = pk2(o[2], o[3]);
            *(u32x2*)(Obf + (size_t)fr * DFF + col) = w;
        }
    }
    __syncthreads();
}

constexpr int XS = 516;
constexpr int TS = 140;
constexpr int SS = 136;
__device__ __forceinline__ bf16x8 ld_lds_2x8(const LAS bf16_t* p0, const LAS bf16_t* p1) { const u32x2 a = *(const LAS u32x2*)p0, b = *(const LAS u32x2*)p1; u32x4 w; w.x = a.x; w.y = a.y; w.z = b.x; w.w = b.y; return __builtin_bit_cast(bf16x8, w); }
__device__ __forceinline__ f32x4 mfma16(bf16x8 a, bf16x8 b, f32x4 c) { return __builtin_amdgcn_mfma_f32_16x16x32_bf16(a, b, c, 0, 0, 0); }

__device__ __forceinline__ u32x4* lc_item(int b, int c, int g, int nt, int mt, int lane) {
    unsigned char* base = (unsigned char*)KA->out + 16 * MiB + (size_t)b * LC_BATCH;
    return (u32x4*)base + ((((size_t)c * 8 + g) * 4 + nt) * 4 + mt) * 64 + lane;
}
__device__ __forceinline__ void lru_unit(LAS unsigned char* lds, int l, int b, int c, bool full, bool nostore = false, bool ldsc = false) {
    const int tid = tidx(), lane = tid & 63, wave = __builtin_amdgcn_readfirstlane(tid >> 6), fr = lane & 15, fq = lane >> 4;
    const int t0 = c == 0 ? 0 : NMETA + 64 * (c - 1), ntok = c == 0 ? NMETA : 64, nmt = ntok >> 4;
    LAS float* xcL = (LAS float*)lds;
    LAS float* part = xcL + 64 * XS;
    bf16_t* P = (bf16_t*)(KA->ws + WS_PROJ) + (size_t)b * TT * DIN;
    bf16x8 wfr[4][4]; float bav[4], bxv[4], c2v[4];
    if (!full) {
        const bf16_t* wt0 = (const bf16_t*)(KA->ws + WS_WAX) + (size_t)(l * 8 + wave) * 2 * 64 * 64;
#pragma unroll
        for (int nt = 0; nt < 4; ++nt) {
            const bf16_t* wr = wt0 + (size_t)(16 * nt + fr) * 64 + 8 * fq;
            wfr[nt][0] = *(const bf16x8*)wr; wfr[nt][1] = *(const bf16x8*)(wr + 32); wfr[nt][2] = *(const bf16x8*)(wr + 64 * 64); wfr[nt][3] = *(const bf16x8*)(wr + 64 * 64 + 32);
            const int chn = l * DLRU + 64 * wave + 16 * nt + fr;
            bav[nt] = -1.4426950408889634f * KA->in[I_GAB][chn]; bxv[nt] = -1.4426950408889634f * KA->in[I_GXB][chn];
            c2v[nt] = -8.0f * 1.4426950408889634f * log1pf(__expf(-KA->in[I_LAM][chn]));
        }
    }
    u32x4 gr[8]; f32x4 og0 = {0.f, 0.f, 0.f, 0.f}, og1 = {0.f, 0.f, 0.f, 0.f};
    if (full && 8 * wave < ntok) {
#pragma unroll
        for (int i = 0; i < 8; ++i) gr[i] = *(const u32x4*)(P + (size_t)(t0 + 8 * wave + i) * DIN + C_GL + 8 * lane);
        const float* ogp = KA->in[I_LRUN] + l * DLRU + 8 * lane; og0 = *(const f32x4*)ogp; og1 = *(const f32x4*)(ogp + 4);
    }
    if (!full) {
        const int tb = 8 * wave, cb8 = 8 * lane;
        if (tb < ntok) {
            u32x4 xr[11];
#pragma unroll
            for (int i = 0; i < 11; ++i) { const int t = t0 + tb + i - 3; xr[i] = (u32x4){0u, 0u, 0u, 0u}; if (t >= 0) xr[i] = *(const u32x4*)(P + (size_t)t * DIN + C_XL + cb8); }
            const float* cw = KA->in[I_CONVW] + (size_t)l * 4 * DLRU + cb8; const float* cbp = KA->in[I_CONVB] + l * DLRU + cb8;
            f32x4 wv[4][2], cbv[2];
#pragma unroll
            for (int k = 0; k < 4; ++k) { wv[k][0] = *(const f32x4*)(cw + k * DLRU); wv[k][1] = *(const f32x4*)(cw + k * DLRU + 4); }
            cbv[0] = *(const f32x4*)cbp; cbv[1] = *(const f32x4*)(cbp + 4);
#pragma unroll
            for (int i = 0; i < 8; ++i) {
                f32x4 o0 = cbv[0], o1 = cbv[1];
#pragma unroll
                for (int k = 0; k < 4; ++k) { const u32x4 w = xr[i + k];
                    const f32x4 a0 = {__uint_as_float(w.x << 16), __uint_as_float(w.x & 0xffff0000u), __uint_as_float(w.y << 16), __uint_as_float(w.y & 0xffff0000u)};
                    const f32x4 a1 = {__uint_as_float(w.z << 16), __uint_as_float(w.z & 0xffff0000u), __uint_as_float(w.w << 16), __uint_as_float(w.w & 0xffff0000u)};
                    o0 += a0 * wv[k][0]; o1 += a1 * wv[k][1]; }
                LAS float* dst = xcL + (tb + i) * XS + cb8; *(LAS f32x4*)dst = o0; *(LAS f32x4*)(dst + 4) = o1;
            }
        }
    }
    __syncthreads();
    const int g = wave;
    bf16x8 xa[4][2];
#pragma unroll
    for (int mt = 0; mt < 4; ++mt)
#pragma unroll
        for (int ks = 0; ks < 2; ++ks) {
            u32x4 w = {0u, 0u, 0u, 0u};
            if (!full && mt < nmt) { const LAS float* p = xcL + (16 * mt + fr) * XS + 64 * g + 32 * ks + 8 * fq; const f32x4 u = *(const LAS f32x4*)p, v = *(const LAS f32x4*)(p + 4);
                w.x = pk2(u[0], u[1]); w.y = pk2(u[2], u[3]); w.z = pk2(v[0], v[1]); w.w = pk2(v[2], v[3]); }
            xa[mt][ks] = __builtin_bit_cast(bf16x8, w);
        }
#pragma unroll
    for (int nt = 0; nt < 4; ++nt) {
        const int ch = 64 * g + 16 * nt + fr;
        const size_t sidx = ((size_t)b * NLC + c) * DLRU + ch;
        float h0 = 0.f, Lacc = 0.f;
        if (!full) {
            const bf16x8 wa0 = wfr[nt][0], wa1 = wfr[nt][1], wx0 = wfr[nt][2], wx1 = wfr[nt][3];
            const float ba = bav[nt], bx = bxv[nt], c2 = c2v[nt];
#pragma unroll
            for (int mt = 0; mt < 4; ++mt) {
                if (mt < nmt) {
                    f32x4 pa = {0.f, 0.f, 0.f, 0.f}, px = {0.f, 0.f, 0.f, 0.f};
                    pa = mfma16(xa[mt][0], wa0, pa); pa = mfma16(xa[mt][1], wa1, pa);
                    px = mfma16(xa[mt][0], wx0, px); px = mfma16(xa[mt][1], wx1, px);
                    float laf[4], ig[4];
#pragma unroll
                    for (int r = 0; r < 4; ++r) {
                        const float ea = 1.0f + __builtin_amdgcn_exp2f(fminf(pa[r] + ba, 57.f)), ex = 1.0f + __builtin_amdgcn_exp2f(fminf(px[r] + bx, 57.f)), inv = frcp(ea * ex);
                        laf[r] = c2 * (ex * inv); ig[r] = ea * inv;
                    }
                    u32x4 cv; cv.x = pg8::cvt_pk_bf16(laf[0], laf[1]); cv.y = pg8::cvt_pk_bf16(laf[2], laf[3]);
                    const float la[4] = {__uint_as_float(cv.x << 16), __uint_as_float(cv.x & 0xffff0000u), __uint_as_float(cv.y << 16), __uint_as_float(cv.y & 0xffff0000u)};
                    float av[4], bbf[4];
#pragma unroll
                    for (int r = 0; r < 4; ++r) { av[r] = __builtin_amdgcn_exp2f(la[r]); bbf[r] = __builtin_amdgcn_sqrtf(fmaxf(1.0f - av[r] * av[r], 0.f)) * ig[r] * xcL[(16 * mt + 4 * fq + r) * XS + ch]; }
                    cv.z = pg8::cvt_pk_bf16(bbf[0], bbf[1]); cv.w = pg8::cvt_pk_bf16(bbf[2], bbf[3]);
                    if (ldsc) { LAS unsigned* cw = (LAS unsigned*)xcL + (16 * mt + 4 * fq) * XS + ch;
                        cw[0] = (cv.x & 0xffffu) | (cv.z << 16); cw[XS] = (cv.x >> 16) | (cv.z & 0xffff0000u); cw[2 * XS] = (cv.y & 0xffffu) | (cv.w << 16); cw[3 * XS] = (cv.y >> 16) | (cv.w & 0xffff0000u); }
                    else *lc_item(b, c, g, nt, mt, lane) = cv;
                    const float bv[4] = {__uint_as_float(cv.z << 16), __uint_as_float(cv.z & 0xffff0000u), __uint_as_float(cv.w << 16), __uint_as_float(cv.w & 0xffff0000u)};
                    float A = 1.f, B = 0.f;
#pragma unroll
                    for (int r = 0; r < 4; ++r) { B = av[r] * B + bv[r]; A = A * av[r]; Lacc += la[r]; }
                    const float pA = __shfl_xor(A, 16), pB = __shfl_xor(B, 16);
                    const float PA = A * pA, PB = (fq & 1) ? A * pB + B : pA * B + pB;
                    const float qA = __shfl_xor(PA, 32), qB = __shfl_xor(PB, 32);
                    const float TA = PA * qA, TB = (fq & 2) ? PA * qB + PB : qA * PB + qB;
                    h0 = TA * h0 + TB;
                }
            }
        } else {
            h0 = ((const float*)(KA->ws + WS_CARRY))[sidx];
            u32x4 cv[4];
#pragma unroll
            for (int mt = 0; mt < 4; ++mt) if (mt < nmt) {
                if (ldsc) { const LAS unsigned* cw = (const LAS unsigned*)xcL + (16 * mt + 4 * fq) * XS + ch; const unsigned w0 = cw[0], w1 = cw[XS], w2 = cw[2 * XS], w3 = cw[3 * XS];
                    cv[mt].x = (w0 & 0xffffu) | (w1 << 16); cv[mt].y = (w2 & 0xffffu) | (w3 << 16); cv[mt].z = (w0 >> 16) | (w1 & 0xffff0000u); cv[mt].w = (w2 >> 16) | (w3 & 0xffff0000u); }
                else cv[mt] = *lc_item(b, c, g, nt, mt, lane);
            }
#pragma unroll
            for (int mt = 0; mt < 4; ++mt) {
                if (mt < nmt) {
                    const float la[4] = {__uint_as_float(cv[mt].x << 16), __uint_as_float(cv[mt].x & 0xffff0000u), __uint_as_float(cv[mt].y << 16), __uint_as_float(cv[mt].y & 0xffff0000u)};
                    const float bv[4] = {__uint_as_float(cv[mt].z << 16), __uint_as_float(cv[mt].z & 0xffff0000u), __uint_as_float(cv[mt].w << 16), __uint_as_float(cv[mt].w & 0xffff0000u)};
                    float Ar[4], Br[4]; float A = 1.f, B = 0.f;
#pragma unroll
                    for (int r = 0; r < 4; ++r) { const float av = __builtin_amdgcn_exp2f(la[r]); B = av * B + bv[r]; A = A * av; Ar[r] = A; Br[r] = B; }
                    const float pA = __shfl_xor(A, 16), pB = __shfl_xor(B, 16);
                    const float PA = A * pA, PB = (fq & 1) ? A * pB + B : pA * B + pB;
                    const float qA = __shfl_xor(PA, 32), qB = __shfl_xor(PB, 32);
                    float hin = h0;
                    if (fq & 2) hin = qA * hin + qB;
                    if (fq & 1) hin = pA * hin + pB;
                    const float TA = PA * qA, TB = (fq & 2) ? PA * qB + PB : qA * PB + qB;
                    h0 = TA * h0 + TB;
#pragma unroll
                    for (int r = 0; r < 4; ++r) xcL[(16 * mt + 4 * fq + r) * XS + ch] = Br[r] + Ar[r] * hin;
                }
            }
        }
        if (!full) {
            Lacc += __shfl_xor(Lacc, 16); Lacc += __shfl_xor(Lacc, 32);
            if (fq == 0) { ((float*)(KA->ws + WS_SUMH))[sidx] = h0; ((float*)(KA->ws + WS_SUML))[sidx] = Lacc; }
        }
    }
    if (full) {
        __syncthreads();
        const int tb = 8 * wave, cb8 = 8 * lane;
        if (tb < ntok) {
#pragma unroll
            for (int i = 0; i < 8; ++i) {
                const LAS float* hp = xcL + (tb + i) * XS + cb8; const f32x4 h0v = *(const LAS f32x4*)hp, h1v = *(const LAS f32x4*)(hp + 4);
                const u32x4 w = gr[i];
                float y[8];
                y[0] = h0v[0] * gelu_tanh(__uint_as_float(w.x << 16)); y[1] = h0v[1] * gelu_tanh(__uint_as_float(w.x & 0xffff0000u));
                y[2] = h0v[2] * gelu_tanh(__uint_as_float(w.y << 16)); y[3] = h0v[3] * gelu_tanh(__uint_as_float(w.y & 0xffff0000u));
                y[4] = h1v[0] * gelu_tanh(__uint_as_float(w.z << 16)); y[5] = h1v[1] * gelu_tanh(__uint_as_float(w.z & 0xffff0000u));
                y[6] = h1v[2] * gelu_tanh(__uint_as_float(w.w << 16)); y[7] = h1v[3] * gelu_tanh(__uint_as_float(w.w & 0xffff0000u));
                float ss = ((y[0] * y[0] + y[1] * y[1]) + (y[2] * y[2] + y[3] * y[3])) + ((y[4] * y[4] + y[5] * y[5]) + (y[6] * y[6] + y[7] * y[7]));
                ss = wave_sum(ss);
                const float rs = __builtin_amdgcn_rsqf(ss * (1.0f / DLRU) + EPS);
                u32x4 o; o.x = pk2(y[0] * rs * og0[0], y[1] * rs * og0[1]); o.y = pk2(y[2] * rs * og0[2], y[3] * rs * og0[3]); o.z = pk2(y[4] * rs * og1[0], y[5] * rs * og1[1]); o.w = pk2(y[6] * rs * og1[2], y[7] * rs * og1[3]);
                if (!nostore) *(u32x4*)(P + (size_t)(t0 + tb + i) * DIN + C_GL + cb8) = o;
            }
        }
    }
    __syncthreads();
}

__device__ __forceinline__ float lg2gamma(int h) { return log2f(1.0f - exp2f(-5.0f - (float)h)); }

constexpr int RS = 144;
typedef short s16x4 __attribute__((ext_vector_type(4)));
template <bool SCALE>
__device__ __forceinline__ void stage_R(LAS bf16_t* img, const bf16_t* P, int t0, int ntok, int col0, float lg, int cpos0, int tid) {
#pragma unroll
    for (int i = 0; i < 4; ++i) {
        const int idx = tid + NTHREADS * i, t = idx >> 4, cc = idx & 15;
        u32x4 w = {0u, 0u, 0u, 0u};
        if (t < ntok) w = *(const u32x4*)(P + (size_t)(t0 + t) * DIN + col0 + 8 * cc);
        if (SCALE) { const float sc = exp2f((float)(127 - (cpos0 + t)) * lg);
#pragma unroll
            for (int q = 0; q < 4; ++q) w[q] = pk2(__uint_as_float(w[q] << 16) * sc, __uint_as_float(w[q] & 0xffff0000u) * sc); }
        *(LAS u32x4*)(img + t * RS + 8 * cc) = w;
    }
}
__device__ __forceinline__ bf16x8 ld_tr(const LAS bf16_t* img, int r0, int r1, int d0, int fr) {
    const int q = fr >> 2, c4 = 4 * (fr & 3);
    const s16x4 x = __builtin_amdgcn_ds_read_tr16_b64_v4i16((LAS s16x4*)(img + (r0 + q) * RS + d0 + c4));
    const s16x4 y = __builtin_amdgcn_ds_read_tr16_b64_v4i16((LAS s16x4*)(img + (r1 + q) * RS + d0 + c4));
    return (bf16x8){x[0], x[1], x[2], x[3], y[0], y[1], y[2], y[3]};
}

struct KvRegs { u32x4 v[4], k[4]; };
__device__ __forceinline__ void kv_issue(KvRegs& R, int b, int n, int h, int tid) {
    const int t0 = n == 0 ? 0 : NMETA + 128 * (n - 1), ntok = n == 0 ? NMETA : 128;
    const bf16_t* P = (const bf16_t*)(KA->ws + WS_PROJ) + (size_t)b * TT * DIN;
#pragma unroll
    for (int i = 0; i < 4; ++i) { const int idx = tid + NTHREADS * i, t = idx >> 4, cc = idx & 15;
        R.v[i] = (u32x4){0u, 0u, 0u, 0u}; R.k[i] = (u32x4){0u, 0u, 0u, 0u};
        if (t < ntok) { const bf16_t* rp = P + (size_t)(t0 + t) * DIN + 128 * h + 8 * cc; R.v[i] = *(const u32x4*)(rp + C_V); R.k[i] = *(const u32x4*)(rp + C_K); } }
}
__device__ __forceinline__ void ret_kv_unit(LAS unsigned char* lds, int b, int n, int h, KvRegs& R, bool has_next, int nb, int nn, int nh) {
    const int tid = tidx(), lane = tid & 63, wave = __builtin_amdgcn_readfirstlane(tid >> 6), fr = lane & 15, fq = lane >> 4;
    const int ntok = n == 0 ? NMETA : 128, cpos0 = n == 0 ? 112 : 0;
    const float lg = lg2gamma(h);
    LAS bf16_t* vI = (LAS bf16_t*)lds; LAS bf16_t* kI = vI + 128 * RS;
#pragma unroll
    for (int i = 0; i < 4; ++i) { const int idx = tid + NTHREADS * i, t = idx >> 4, cc = idx & 15;
        *(LAS u32x4*)(vI + t * RS + 8 * cc) = R.v[i];
        const float sc = exp2f((float)(127 - (cpos0 + t)) * lg); u32x4 w = R.k[i];
#pragma unroll
        for (int q = 0; q < 4; ++q) w[q] = pk2(__uint_as_float(w[q] << 16) * sc, __uint_as_float(w[q] & 0xffff0000u) * sc);
        *(LAS u32x4*)(kI + t * RS + 8 * cc) = w; }
    __syncthreads();
    if (has_next) kv_issue(R, nb, nn, nh, tid);
    f32x4 acc[8];
#pragma unroll
    for (int dt = 0; dt < 8; ++dt) acc[dt] = (f32x4){0.f, 0.f, 0.f, 0.f};
    const int nkt = (ntok + 31) >> 5;
    for (int kt = 0; kt < nkt; ++kt) {
        const int r0 = 32 * kt + 8 * fq;
        const bf16x8 vf = ld_tr(vI, r0, r0 + 4, 16 * wave, fr);
#pragma unroll
        for (int dt = 0; dt < 8; ++dt) acc[dt] = mfma16(ld_tr(kI, r0, r0 + 4, 16 * dt, fr), vf, acc[dt]);
    }
    bf16_t* S = (bf16_t*)KA->out + ((size_t)((b * NH + h) * 16 + n)) * 16384 + (size_t)(16 * wave + fr) * 128 + 4 * fq;
#pragma unroll
    for (int dt = 0; dt < 8; ++dt) { u32x2 w; w.x = pk2(acc[dt][0], acc[dt][1]); w.y = pk2(acc[dt][2], acc[dt][3]); *(u32x2*)(S + 16 * dt) = w; }
    __syncthreads();
}

struct RetRegs { u32x4 v[4], k[4], s[4]; };
__device__ __forceinline__ void ret_issue(RetRegs& R, int b, int n, int h, int tid) {
    const int t0 = n == 0 ? 0 : NMETA + 128 * (n - 1), ntok = n == 0 ? NMETA : 128;
    const bf16_t* P = (const bf16_t*)(KA->ws + WS_PROJ) + (size_t)b * TT * DIN;
    const bf16_t* S = (const bf16_t*)KA->out + ((size_t)((b * NH + h) * 16 + (n >= 1 ? n - 1 : 0))) * 16384;
#pragma unroll
    for (int i = 0; i < 4; ++i) { const int idx = tid + NTHREADS * i, t = idx >> 4, cc = idx & 15;
        R.v[i] = (u32x4){0u, 0u, 0u, 0u}; R.k[i] = (u32x4){0u, 0u, 0u, 0u}; R.s[i] = (u32x4){0u, 0u, 0u, 0u};
        if (t < ntok) { const bf16_t* rp = P + (size_t)(t0 + t) * DIN + 128 * h + 8 * cc; R.v[i] = *(const u32x4*)(rp + C_V); R.k[i] = *(const u32x4*)(rp + C_K); }
        if (n >= 1) R.s[i] = *(const u32x4*)(S + t * 128 + 8 * cc); }
}
__device__ __forceinline__ void ret_out_unit(LAS unsigned char* lds, int l, int b, int n, int h, RetRegs& R, bool has_next, int nb, int nn, int nh) {
    const bool nostore = false;
    const int tid = tidx(), lane = tid & 63, wave = __builtin_amdgcn_readfirstlane(tid >> 6), fr = lane & 15, fq = lane >> 4;
    const int t0 = n == 0 ? 0 : NMETA + 128 * (n - 1), ntok = n == 0 ? NMETA : 128;
    const float lg = lg2gamma(h);
    LAS bf16_t* vI = (LAS bf16_t*)lds; LAS bf16_t* SL = vI + 128 * RS; LAS bf16_t* kL = SL + 128 * SS;
    bf16_t* P = (bf16_t*)(KA->ws + WS_PROJ) + (size_t)b * TT * DIN;
#pragma unroll
    for (int i = 0; i < 4; ++i) { const int idx = tid + NTHREADS * i, t = idx >> 4, cc = idx & 15;
        *(LAS u32x4*)(vI + t * RS + 8 * cc) = R.v[i]; *(LAS u32x4*)(kL + t * SS + 8 * cc) = R.k[i];
        if (n >= 1) *(LAS u32x4*)(SL + t * SS + 8 * cc) = R.s[i]; }
    __syncthreads();
    if (has_next) ret_issue(R, nb, nn, nh, tid);
    if (16 * wave < ntok) {
        const int c = 16 * wave + fr;
        bf16_t* qrow = P + (size_t)(t0 + c) * DIN + 128 * h;
        bf16x8 qf[4];
#pragma unroll
        for (int kd = 0; kd < 4; ++kd) qf[kd] = *(const bf16x8*)(qrow + C_Q + 32 * kd + 8 * fq);
        f32x4 y[8];
#pragma unroll
        for (int et = 0; et < 8; ++et) y[et] = (f32x4){0.f, 0.f, 0.f, 0.f};
        if (n >= 1) {
            const float xi = exp2f((float)(c + 1) * lg);
#pragma unroll
            for (int et = 0; et < 8; ++et) {
#pragma unroll
                for (int kd = 0; kd < 4; ++kd) y[et] = mfma16(*(const LAS bf16x8*)(SL + (16 * et + fr) * SS + 32 * kd + 8 * fq), qf[kd], y[et]);
                y[et] = y[et] * xi;
            }
        }
        for (int p = 0; p <= (wave >> 1); ++p) {
            f32x4 sc0 = {0.f, 0.f, 0.f, 0.f}, sc1 = {0.f, 0.f, 0.f, 0.f};
            { const LAS bf16_t* kr = kL + (32 * p + fr) * SS + 8 * fq;
#pragma unroll
              for (int kd = 0; kd < 4; ++kd) sc0 = mfma16(*(const LAS bf16x8*)(kr + 32 * kd), qf[kd], sc0); }
            if (2 * p + 1 <= wave) { const LAS bf16_t* kr = kL + (32 * p + 16 + fr) * SS + 8 * fq;
#pragma unroll
              for (int kd = 0; kd < 4; ++kd) sc1 = mfma16(*(const LAS bf16x8*)(kr + 32 * kd), qf[kd], sc1); }
            float pv[8];
#pragma unroll
            for (int j = 0; j < 4; ++j) { const int s0 = 32 * p + 4 * fq + j, s1 = s0 + 16;
                pv[j] = (c >= s0) ? sc0[j] * __builtin_amdgcn_exp2f((float)(c - s0) * lg) : 0.f; pv[4 + j] = (c >= s1) ? sc1[j] * __builtin_amdgcn_exp2f((float)(c - s1) * lg) : 0.f; }
            u32x4 w; w.x = pk2(pv[0], pv[1]); w.y = pk2(pv[2], pv[3]); w.z = pk2(pv[4], pv[5]); w.w = pk2(pv[6], pv[7]);
            const bf16x8 pf = __builtin_bit_cast(bf16x8, w);
#pragma unroll
            for (int et = 0; et < 8; ++et) y[et] = mfma16(ld_tr(vI, 32 * p + 4 * fq, 32 * p + 16 + 4 * fq, 16 * et, fr), pf, y[et]);
        }
        float s1 = 0.f;
#pragma unroll
        for (int et = 0; et < 8; ++et) s1 += (y[et][0] + y[et][1]) + (y[et][2] + y[et][3]);
        s1 += __shfl_xor(s1, 16); s1 += __shfl_xor(s1, 32);
        const float mu = s1 * (1.0f / 128.0f);
        float s2 = 0.f;
#pragma unroll
        for (int et = 0; et < 8; ++et) { y[et] = y[et] - mu; s2 += (y[et][0] * y[et][0] + y[et][1] * y[et][1]) + (y[et][2] * y[et][2] + y[et][3] * y[et][3]); }
        s2 += __shfl_xor(s2, 16); s2 += __shfl_xor(s2, 32);
        const float rs = rsqrtf(s2 * (1.0f / 128.0f) + EPS);
        const float* gn = KA->in[I_RETN] + l * 512 + 128 * h + 4 * fq;
#pragma unroll
        for (int et = 0; et < 8; ++et) {
            const u32x2 gw = *(const u32x2*)(qrow + C_GR + 16 * et + 4 * fq); const f32x4 gv = *(const f32x4*)(gn + 16 * et);
            const float g0 = __uint_as_float(gw.x << 16), g1 = __uint_as_float(gw.x & 0xffff0000u), g2 = __uint_as_float(gw.y << 16), g3 = __uint_as_float(gw.y & 0xffff0000u);
            u32x2 o; o.x = pk2(y[et][0] * rs * gv[0] * g0 * sigmoidf_(g0), y[et][1] * rs * gv[1] * g1 * sigmoidf_(g1)); o.y = pk2(y[et][2] * rs * gv[2] * g2 * sigmoidf_(g2), y[et][3] * rs * gv[3] * g3 * sigmoidf_(g3));
            if (!nostore) *(u32x2*)(qrow + C_V + 16 * et + 4 * fq) = o;
        }
    }
    __syncthreads();
}

__device__ __forceinline__ void prefix_phase(int G, bool nostore = false) {
    const int gt = bidx() * NTHREADS + tidx(), NGT = G * NTHREADS;
    bf16_t* SB = (bf16_t*)KA->out;
    for (int i = gt; i < NB * NH * 4096; i += NGT) {
        const int bh = i >> 12, ed = (i & 4095) * 4, h = bh & 3;
        const float g128 = exp2f(128.0f * lg2gamma(h));
        u32x2* base = (u32x2*)(SB + (size_t)bh * 16 * 16384 + ed);
        u32x2 v[16];
#pragma unroll
        for (int n = 0; n < 16; ++n) v[n] = base[(size_t)n * 4096];
        f32x4 run = {__uint_as_float(v[0].x << 16), __uint_as_float(v[0].x & 0xffff0000u), __uint_as_float(v[0].y << 16), __uint_as_float(v[0].y & 0xffff0000u)};
#pragma unroll
        for (int n = 1; n < 16; ++n) {
            const f32x4 kv = {__uint_as_float(v[n].x << 16), __uint_as_float(v[n].x & 0xffff0000u), __uint_as_float(v[n].y << 16), __uint_as_float(v[n].y & 0xffff0000u)};
            run = run * g128 + kv;
            u32x2 w; w.x = pk2(run[0], run[1]); w.y = pk2(run[2], run[3]);
            if (!nostore) base[(size_t)n * 4096] = w;
        }
    }
    const float* sh = (const float*)(KA->ws + WS_SUMH); const float* sl = (const float*)(KA->ws + WS_SUML); float* cr = (float*)(KA->ws + WS_CARRY);
    for (int i = gt; i < NB * DLRU; i += NGT) {
        const int b = i >> 9, ch = i & 511; const size_t i0 = (size_t)b * NLC * DLRU + ch;
        float hh[NLC], ll[NLC];
#pragma unroll
        for (int c = 0; c < NLC; ++c) { hh[c] = sh[i0 + (size_t)c * DLRU]; ll[c] = sl[i0 + (size_t)c * DLRU]; }
        float h = 0.f;
#pragma unroll
        for (int c = 0; c < NLC; ++c) { if (!nostore) cr[i0 + (size_t)c * DLRU] = h; h = hh[c] + __builtin_amdgcn_exp2f(ll[c]) * h; }
    }
}

constexpr int N_PHASES = 2 + 7 * DEPTH;

__global__ void __launch_bounds__(NTHREADS, 2) hymba_fwd(Args a) {
    extern __shared__ __attribute__((aligned(16))) unsigned char lds_raw[];
    LAS unsigned char* lds = (LAS unsigned char*)lds_raw;
    const int G = gridDim.x;
#if MK_PER_PHASE
    const int lo = KA->ph_lo, hi = KA->ph_hi;
#define IN(k) (lo <= (k) && (k) < hi)
#define SEAM(k) do { } while (0)
#else
#define IN(k) true
#define SEAM(k) do { XcdBarrier b_; b_.bar = (unsigned*)(KA->ws); b_.x = xb_xcc_id(); b_.st = (volatile LAS unsigned*)(lds + LDS_BYTES - 64); xcd_barrier(b_); } while (0)
#endif
#define P_HB ((bf16_t*)(KA->ws + WS_HB))
#define P_PROJ ((bf16_t*)(KA->ws + WS_PROJ))
#define P_SSQ ((float*)(KA->ws + WS_SSQ))
#define P_HM ((float*)(KA->ws + WS_HM))
#define P_ROPE ((const f32x2*)(KA->ws + WS_ROPE))
#define P_W(l) ((const bf16_t*)(KA->ws + WS_W) + (size_t)(l) * W_LAYER_E)
    int ph = 0;
#if !MK_PER_PHASE
    if (threadIdx.x < 16) ((LAS unsigned*)(lds + LDS_BYTES - 64))[threadIdx.x] = 0u;
    __syncthreads();
    (void)xcd_barrier_post((unsigned*)(KA->ws), (volatile LAS unsigned*)(lds + LDS_BYTES - 64));
#endif

    if (IN(ph)) prologue(lds, G);
#ifdef PROBE_DUP_PRO
    prologue(lds, G);
#endif
#if !MK_PER_PHASE
    SEAM(ph);
    if (KA->ph_hi == 0x7fffffff) cg::this_grid().sync();
#endif
    ++ph;

    for (int l = 0; l < DEPTH; ++l) {
        if (IN(ph)) {
            { pg8::Gemm g{P_HB, P_W(l), DM, DIN, DM}; pg8::StaticOrder S; S.init(MROWS, DIN, G, bidx(), 2);
              pg8::fill_rstd_tables(lds, P_SSQ, S);
              pg8::EpiProj E{P_PROJ, (const LAS float*)(lds + pg8::RSTD_OFF), P_ROPE};
              pg8::gemm_phase<pg8::EpiProj, true, true>(lds, g, S, E);
#ifdef PROBE_DUP_G1
              pg8::gemm_phase<pg8::EpiProj, true, true>(lds, g, S, E);
#endif
            }
            if (bidx() < DIN / 16) skinny_item<0, DM>(lds, bidx(), P_HM, nullptr, 0, P_W(l), nullptr, P_PROJ, P_ROPE);
        }
        SEAM(ph); ++ph;
        if (IN(ph)) {
            constexpr int NL = NB * NLC, NR = NB * 16 * NH;
            const bool ldsc = G >= 256;
            int u = bidx() + 256;
            for (; u < NL; u += G) lru_unit(lds, l, u - 256, 0, false);
            if (u < NL + NR) {
                KvRegs R; int r = u - NL, kb, kn, kh;
                if (r < 480) { kb = r / 60; kn = 1 + ((r % 60) >> 2); kh = r & 3; } else { kb = (r - 480) >> 2; kn = 0; kh = r & 3; }
                kv_issue(R, kb, kn, kh, tidx());
                for (;;) {
                    const int rn = r + G; const bool hn = rn < NR; int nb2 = 0, nn2 = 0, nh2 = 0;
                    if (hn) { if (rn < 480) { nb2 = rn / 60; nn2 = 1 + ((rn % 60) >> 2); nh2 = rn & 3; } else { nb2 = (rn - 480) >> 2; nn2 = 0; nh2 = rn & 3; } }
                    ret_kv_unit(lds, kb, kn, kh, R, hn, nb2, nn2, nh2);
                    if (!hn) break;
                    r = rn; kb = nb2; kn = nn2; kh = nh2;
                }
            }
            for (int u = bidx(); u < 256; u += G) lru_unit(lds, l, u >> 5, 1 + (u & 31), false, false, ldsc);
        }
#ifdef PROBE_DUP_SYNC
        SEAM(ph); SEAM(ph); SEAM(ph); SEAM(ph); SEAM(ph); SEAM(ph); SEAM(ph);
#endif
        SEAM(ph); ++ph;
#ifdef PROBE_DRY_M15
        prefix_phase(G, KA->ph_lo == 0);
#endif
        if (IN(ph)) prefix_phase(G);
        SEAM(ph); ++ph;
        if (IN(ph)) {
            constexpr int NL = NB * NLC, NR = NB * NRC * NH;
            const bool ldsc = G >= 256;
            for (int u = bidx(); u < 256; u += G) lru_unit(lds, l, u >> 5, 1 + (u & 31), true, false, ldsc);
            int u = bidx() + 256;
            for (; u < NL; u += G) lru_unit(lds, l, u - 256, 0, true);
            if (u < NL + NR) {
                RetRegs R; int r = u - NL, rb, rn_, rh;
                if (r < 512) { rb = r >> 6; rn_ = 1 + ((r >> 2) & 15); rh = r & 3; } else { rb = (r - 512) >> 2; rn_ = 0; rh = r & 3; }
                ret_issue(R, rb, rn_, rh, tidx());
                for (;;) {
                    const int r2 = r + G; const bool hn = r2 < NR; int nb2 = 0, nn2 = 0, nh2 = 0;
                    if (hn) { if (r2 < 512) { nb2 = r2 >> 6; nn2 = 1 + ((r2 >> 2) & 15); nh2 = r2 & 3; } else { nb2 = (r2 - 512) >> 2; nn2 = 0; nh2 = r2 & 3; } }
                    ret_out_unit(lds, l, rb, rn_, rh, R, hn, nb2, nn2, nh2);
                    if (!hn) break;
                    r = r2; rb = nb2; rn_ = nn2; rh = nh2;
                }
            }
        }
        SEAM(ph); ++ph;
        if (IN(ph)) {
            { pg8::Gemm g{P_PROJ + C_GL, P_W(l) + W_IN_E, DIN, DM, DM}; pg8::StaticOrder S; S.init(MROWS, DM, G, bidx());
#ifdef PROBE_DRY_G24
              { pg8::EpiDry Ed{P_SSQ}; pg8::gemm_phase<pg8::EpiDry, false, true>(lds, g, S, Ed); }
#endif

              pg8::EpiRes E{P_HB, P_SSQ};
              pg8::gemm_phase<pg8::EpiRes, false, true>(lds, g, S, E); }
            if (bidx() < DM / 16) skinny_item<1, DM>(lds, bidx(), nullptr, P_PROJ + C_GL, DIN, P_W(l) + W_IN_E, P_HM, nullptr, nullptr);
        }
        SEAM(ph); ++ph;
        if (IN(ph)) {
            { pg8::Gemm g{P_HB, P_W(l) + W_IN_E + W_OUT_E, DM, 2 * DFF, DM}; pg8::StaticOrder S; S.init(MROWS, 2 * DFF, G, bidx());
              pg8::fill_rstd_tables(lds, P_SSQ, S);
              pg8::EpiGlu E{P_PROJ, (const LAS float*)(lds + pg8::RSTD_OFF)};
              pg8::gemm_phase<pg8::EpiGlu, true, true>(lds, g, S, E);
#ifdef PROBE_DUP_G3
              pg8::gemm_phase<pg8::EpiGlu, true, true>(lds, g, S, E);
#endif
            }
            for (int i = bidx() - G / 2; i >= 0 && i < DFF / 16; i += G / 2) skinny_item<2, DM>(lds, i, P_HM, nullptr, 0, P_W(l) + W_IN_E + W_OUT_E, nullptr, P_PROJ, nullptr);
        }
        SEAM(ph); ++ph;
        if (IN(ph)) {
            { pg8::Gemm g{P_PROJ, P_W(l) + W_IN_E + W_OUT_E + W_GU_E, DFF, DM, DFF}; pg8::StaticOrder S; S.init(MROWS, DM, G, bidx());
#ifdef PROBE_DRY_G24
              { pg8::EpiDry Ed{P_SSQ}; pg8::gemm_phase<pg8::EpiDry, false, true>(lds, g, S, Ed); }
#endif

              pg8::EpiRes E{P_HB, P_SSQ};
              pg8::gemm_phase<pg8::EpiRes, false, true>(lds, g, S, E); }
            if (bidx() < DM / 16) skinny_item<1, DFF>(lds, bidx(), nullptr, P_PROJ, DFF, P_W(l) + W_IN_E + W_OUT_E + W_GU_E, P_HM, nullptr, nullptr);
        }
        SEAM(ph); ++ph;
    }
    if (IN(ph)) {
        const int tid = tidx(), lane = tid & 63, gw = bidx() * 8 + (tid >> 6), NGW = G * 8;
        const float* gnp = KA->in[I_NFIN] + 8 * lane; const f32x4 g0 = *(const f32x4*)gnp, g1 = *(const f32x4*)(gnp + 4), g2 = *(const f32x4*)(gnp + 512), g3 = *(const f32x4*)(gnp + 516);
        const float* ssq = P_SSQ; float* outp = KA->out; const bf16_t* hbp = P_HB;
        for (int m0 = gw; m0 < MROWS; m0 += 4 * NGW) {
            f32x4 sq[4][4]; u32x4 ha[4], hb2[4];
#pragma unroll
            for (int q = 0; q < 4; ++q) { const int m = m0 + q * NGW; if (m < MROWS) {
                const f32x4* sp = (const f32x4*)(ssq + (size_t)m * 16); sq[q][0] = sp[0]; sq[q][1] = sp[1]; sq[q][2] = sp[2]; sq[q][3] = sp[3];
                const u32x4* hr = (const u32x4*)(hbp + (size_t)rowX(m) * DM) + lane; ha[q] = hr[0]; hb2[q] = hr[64]; } }
#pragma unroll
            for (int q = 0; q < 4; ++q) { const int m = m0 + q * NGW; if (m < MROWS) {
                const f32x4 t = (sq[q][0] + sq[q][1]) + (sq[q][2] + sq[q][3]);
                const float rs = rsqrtf(((t[0] + t[1]) + (t[2] + t[3])) * (1.0f / DM) + EPS);
                const u32x4 a = ha[q], b = hb2[q];
                f32x4* xr = (f32x4*)(outp + (size_t)m * DM) + 2 * lane;
                xr[0] = (f32x4){__uint_as_float(a.x << 16), __uint_as_float(a.x & 0xffff0000u), __uint_as_float(a.y << 16), __uint_as_float(a.y & 0xffff0000u)} * rs * g0;
                xr[1] = (f32x4){__uint_as_float(a.z << 16), __uint_as_float(a.z & 0xffff0000u), __uint_as_float(a.w << 16), __uint_as_float(a.w & 0xffff0000u)} * rs * g1;
                xr[128] = (f32x4){__uint_as_float(b.x << 16), __uint_as_float(b.x & 0xffff0000u), __uint_as_float(b.y << 16), __uint_as_float(b.y & 0xffff0000u)} * rs * g2;
                xr[129] = (f32x4){__uint_as_float(b.z << 16), __uint_as_float(b.z & 0xffff0000u), __uint_as_float(b.w << 16), __uint_as_float(b.w & 0xffff0000u)} * rs * g3; } }
        }
    }
#undef IN
#undef SEAM
}

#ifndef MK_PER_PHASE
#define MK_PER_PHASE 0
#endif
extern "C" void kernel_launch(void* const* d_in, const int* in_sizes, int n_in, void* d_out, int out_size, void* d_ws, size_t ws_size, hipStream_t stream) {
    static int grid = 0;
    if (grid == 0) {
        if (n_in != 19 || out_size != MROWS * DM || ws_size < WS_END) { fprintf(stderr, "kernel_launch: unexpected shapes (n_in %d out %d ws %zu)\n", n_in, out_size, ws_size); grid = -1; return; }
        int dev = 0, cus = 0, per_cu = 0;
        hipGetDevice(&dev); hipDeviceGetAttribute(&cus, hipDeviceAttributeMultiprocessorCount, dev);
        if (hipFuncSetAttribute((const void*)hymba_fwd, hipFuncAttributeMaxDynamicSharedMemorySize, LDS_BYTES) != hipSuccess) { fprintf(stderr, "kernel_launch: hipFuncSetAttribute failed\n"); grid = -1; return; }
        if (hipOccupancyMaxActiveBlocksPerMultiprocessor(&per_cu, (const void*)hymba_fwd, NTHREADS, LDS_BYTES) != hipSuccess || per_cu < 1) { fprintf(stderr, "kernel_launch: occupancy query says %d\n", per_cu); per_cu = 1; }
        (void)hipGetLastError();
        grid = cus * 1;
        if (grid <= 0) grid = 256;
    }
    if (grid < 0) return;
    if (hipMemsetAsync(d_ws, 0, 65536, stream) != hipSuccess) { fprintf(stderr, "kernel_launch: memset failed\n"); return; }
    Args a{};
    for (int i = 0; i < 19; ++i) a.in[i] = (const float*)d_in[i];
    a.out = (float*)d_out; a.ws = (unsigned char*)d_ws;
#if MK_PER_PHASE
    for (int p = 0; p < N_PHASES; ++p) { a.ph_lo = p; a.ph_hi = p + 1; hipLaunchKernelGGL(hymba_fwd, dim3(grid), dim3(NTHREADS), LDS_BYTES, stream, a); }
#else
    a.ph_lo = 0; a.ph_hi = N_PHASES;
    void* args[] = {&a};
    hipError_t e = hipLaunchCooperativeKernel((const void*)hymba_fwd, dim3(grid), dim3(NTHREADS), args, LDS_BYTES, stream);
    if (e != hipSuccess) fprintf(stderr, "cooperative launch failed: %s (grid %d)\n", hipGetErrorString(e), grid);
#endif
}
```
